# Optimizing an MI355X kernel written in HIP

```python
import math
import jax, jax.numpy as jnp
from jax import lax
import numpy as np

D_MODEL = 1024
BATCH = 8
SEQ = 4096
DEPTH = 1
DEC_BATCH = 16
DEC_SEQ = 4096
PAST_LEN = 128

N_HEADS = 16
N_KV_HEADS = 4
HEAD_DIM = 64
Q_PER_KV = N_HEADS // N_KV_HEADS
WINDOW = 128
BLOCK = 128
N_BUCKETS = 32
MAX_DISTANCE = 128
ATTN_Q = N_HEADS * HEAD_DIM
ATTN_KV = N_KV_HEADS * HEAD_DIM
NEG_INF = -1e30
SSM_WIDTH = D_MODEL
SSM_GROUP = 16
SSM_GROUPS = SSM_WIDTH // SSM_GROUP
SSM_STATE = 64
N_DIR = 2
DT_MIN = 0.001
DT_MAX = 0.1
D_FF = 4 * D_MODEL
EPS = 1e-6
IN_SPLITS = (ATTN_Q, ATTN_Q + ATTN_KV, ATTN_Q + 2 * ATTN_KV,
             ATTN_Q + 2 * ATTN_KV + SSM_WIDTH,
             ATTN_Q + 2 * ATTN_KV + SSM_WIDTH + D_MODEL)
IN_COLS = ATTN_Q + 2 * ATTN_KV + SSM_WIDTH + 2 * D_MODEL

kernel_name = "hybrid_s5_window_gqa_encoder"


def rms_norm(x, g):
    xf = x.astype(jnp.float32)
    y = xf * lax.rsqrt(jnp.mean(xf * xf, axis=-1, keepdims=True) + EPS)
    return (y * g.astype(jnp.float32)).astype(x.dtype)


def t5_bucket(rel):
    nb = N_BUCKETS // 2
    ret = (rel > 0).astype(np.int32) * nb
    n = np.abs(rel)
    max_exact = nb // 2
    n_safe = np.maximum(n, 1).astype(np.float32)
    large = max_exact + (np.log(n_safe / max_exact) / math.log(MAX_DISTANCE / max_exact)
                         * (nb - max_exact)).astype(np.int32)
    large = np.minimum(large, nb - 1)
    return (ret + np.where(n < max_exact, n, large)).astype(np.int32)


def band_bias(rel_table):
    qi = np.arange(BLOCK)[:, None]
    kj = np.arange(3 * BLOCK)[None, :]
    buckets = t5_bucket(kj - BLOCK - qi)
    bias = rel_table.astype(jnp.float32)[buckets]
    bias = jnp.transpose(bias, (2, 0, 1))
    return bias.reshape(N_KV_HEADS, Q_PER_KV, BLOCK, 3 * BLOCK)


def band_mask(seq_len):
    n_blocks = seq_len // BLOCK
    nb = jnp.arange(n_blocks)[:, None, None]
    qi = jnp.arange(BLOCK)[None, :, None]
    kj = jnp.arange(3 * BLOCK)[None, None, :]
    rel = kj - BLOCK - qi
    key_pos = nb * BLOCK - BLOCK + kj
    return (jnp.abs(rel) <= WINDOW) & (key_pos >= 0) & (key_pos < seq_len)


def windowed_attention(q, k, v, sink, bias, mask):
    seq_len = q.shape[1]
    n_blocks = seq_len // BLOCK
    scale = HEAD_DIM ** -0.5
    sink_b = sink.astype(jnp.float32).reshape(1, N_KV_HEADS, Q_PER_KV, 1, 1)

    def neighbours(t):
        tb = t.reshape(n_blocks, BLOCK, N_KV_HEADS, HEAD_DIM)
        tp = jnp.pad(tb, ((1, 1), (0, 0), (0, 0), (0, 0)))
        return jnp.concatenate([tp[:-2], tp[1:-1], tp[2:]], axis=1)

    def attend_one(args):
        qs, ks, vs = args
        qb = qs.reshape(n_blocks, BLOCK, N_KV_HEADS, Q_PER_KV, HEAD_DIM)
        kw, vw = neighbours(ks), neighbours(vs)
        s = jnp.einsum('nqkgd,njkd->nkgqj', qb, kw).astype(jnp.float32) * scale + bias
        s = jnp.where(mask[:, None, None], s, NEG_INF)
        sink_col = jnp.broadcast_to(sink_b, s.shape[:-1] + (1,))
        p = jax.nn.softmax(jnp.concatenate([s, sink_col], axis=-1), axis=-1)[..., :-1]
        o = jnp.einsum('nkgqj,njkd->nqkgd', p.astype(vs.dtype), vw)
        return o.reshape(seq_len, ATTN_Q)

    return lax.map(attend_one, (q, k, v))


def s5_discretize(lam_re, lam_im, log_dt, b_re, b_im):
    dt = jnp.exp(log_dt.astype(jnp.float32))[..., None]
    lr, li = lam_re.astype(jnp.float32), lam_im.astype(jnp.float32)
    mag = jnp.exp(lr * dt)
    ang = li * dt
    a_re, a_im = mag * jnp.cos(ang), mag * jnp.sin(ang)
    den = lr * lr + li * li
    nr, ni = a_re - 1.0, a_im
    c_re = (nr * lr + ni * li) / den
    c_im = (ni * lr - nr * li) / den
    br, bi = b_re.astype(jnp.float32), b_im.astype(jnp.float32)
    bb_re = c_re[..., None] * br - c_im[..., None] * bi
    bb_im = c_re[..., None] * bi + c_im[..., None] * br
    return a_re, a_im, bb_re, bb_im


def _complex_combine(e1, e2):
    a1r, a1i, b1r, b1i = e1
    a2r, a2i, b2r, b2i = e2
    return (a2r * a1r - a2i * a1i,
            a2r * a1i + a2i * a1r,
            a2r * b1r - a2i * b1i + b2r,
            a2r * b1i + a2i * b1r + b2i)


def s5_branch(u, lam_re, lam_im, log_dt, b_re, b_im, c_re, c_im, d_skip, w_glu, b_glu):
    a_re, a_im, bb_re, bb_im = s5_discretize(lam_re, lam_im, log_dt, b_re, b_im)
    cr, ci = c_re.astype(jnp.float32), c_im.astype(jnp.float32)
    dsk = d_skip.astype(jnp.float32)

    def one_direction(us, d, reverse):
        bu_re = jnp.einsum('lgc,gpc->lgp', us, bb_re[d])
        bu_im = jnp.einsum('lgc,gpc->lgp', us, bb_im[d])
        ar = jnp.broadcast_to(a_re[d], bu_re.shape)
        ai = jnp.broadcast_to(a_im[d], bu_re.shape)
        _, _, h_re, h_im = lax.associative_scan(_complex_combine, (ar, ai, bu_re, bu_im),
                                                reverse=reverse, axis=0)
        return (jnp.einsum('lgp,gcp->lgc', h_re, cr[d])
                - jnp.einsum('lgp,gcp->lgc', h_im, ci[d]))

    def one_seq(us):
        seq_len = us.shape[0]
        uf = us.astype(jnp.float32)
        ug = uf.reshape(seq_len, SSM_GROUPS, SSM_GROUP)
        y = one_direction(ug, 0, False) + one_direction(ug, 1, True)
        return (y.reshape(seq_len, SSM_WIDTH) + dsk * uf).astype(us.dtype)

    y = jax.nn.gelu(lax.map(one_seq, u))
    return y * jax.nn.sigmoid(y @ w_glu + b_glu)


def encoder_layer(x, bias, ln1, w_in, q_gain, k_gain, sink, lam_re, lam_im, log_dt,
                  b_re, b_im, c_re, c_im, d_skip, w_glu, b_glu, w_out, ln2, w_up, w_down):
    bsz, seq_len, _ = x.shape
    h = rms_norm(x, ln1)
    proj = h @ w_in
    q, k, v, u, g_att, g_ssm = jnp.split(proj, IN_SPLITS, axis=-1)
    q = rms_norm(q.reshape(bsz, seq_len, N_HEADS, HEAD_DIM), q_gain)
    k = rms_norm(k.reshape(bsz, seq_len, N_KV_HEADS, HEAD_DIM), k_gain)
    v = v.reshape(bsz, seq_len, N_KV_HEADS, HEAD_DIM)
    y_att = windowed_attention(q, k, v, sink, bias, band_mask(seq_len))
    y_ssm = s5_branch(u, lam_re, lam_im, log_dt, b_re, b_im, c_re, c_im,
                      d_skip, w_glu, b_glu)
    mixed = jax.nn.sigmoid(g_att) * y_att + jax.nn.sigmoid(g_ssm) * y_ssm
    x = x + mixed @ w_out
    h2 = rms_norm(x, ln2)
    return x + jnp.square(jax.nn.relu(h2 @ w_up)) @ w_down


def trunk(x, rel_table, ln1, w_in, q_gain, k_gain, sink, lam_re, lam_im, log_dt,
          b_re, b_im, c_re, c_im, d_skip, w_glu, b_glu, w_out, ln2, w_up, w_down):
    bias = band_bias(rel_table)
    for l in range(DEPTH):
        x = encoder_layer(x, bias, ln1[l], w_in[l], q_gain[l], k_gain[l], sink[l],
                          lam_re[l], lam_im[l], log_dt[l], b_re[l], b_im[l],
                          c_re[l], c_im[l], d_skip[l], w_glu[l], b_glu[l], w_out[l],
                          ln2[l], w_up[l], w_down[l])
    return x


def setup_inputs(seed: int = 0) -> dict:
    key = jax.random.key(seed)
    ks = jax.random.split(key, 24)
    nrm = jax.random.normal
    f32 = jnp.float32
    G, P, C = SSM_GROUPS, SSM_STATE, SSM_GROUP
    lam_im_base = jnp.broadcast_to(jnp.pi * jnp.arange(P, dtype=f32), (DEPTH, N_DIR, G, P))
    return {
        "x_prompt": nrm(ks[0], (BATCH, SEQ, D_MODEL), f32),
        "x_sample": nrm(ks[1], (DEC_BATCH, DEC_SEQ, D_MODEL), f32),
        "rel_table": 0.2 * nrm(ks[2], (N_BUCKETS, N_HEADS), f32),
        "ln1": 1.0 + 0.02 * nrm(ks[3], (DEPTH, D_MODEL), f32),
        "w_in": nrm(ks[4], (DEPTH, D_MODEL, IN_COLS), f32) * D_MODEL ** -0.5,
        "q_gain": 1.0 + 0.02 * nrm(ks[5], (DEPTH, HEAD_DIM), f32),
        "k_gain": 1.0 + 0.02 * nrm(ks[6], (DEPTH, HEAD_DIM), f32),
        "sink": 0.5 * nrm(ks[7], (DEPTH, N_HEADS), f32),
        "lam_re": -0.5 + 0.01 * nrm(ks[8], (DEPTH, N_DIR, G, P), f32),
        "lam_im": lam_im_base + 0.01 * nrm(ks[9], (DEPTH, N_DIR, G, P), f32),
        "log_dt": jax.random.uniform(ks[10], (DEPTH, N_DIR, G), f32,
                                     math.log(DT_MIN), math.log(DT_MAX)),
        "b_re": nrm(ks[11], (DEPTH, N_DIR, G, P, C), f32) * (2.0 * C) ** -0.5,
        "b_im": nrm(ks[12], (DEPTH, N_DIR, G, P, C), f32) * (2.0 * C) ** -0.5,
        "c_re": nrm(ks[13], (DEPTH, N_DIR, G, C, P), f32) * (2.0 * P) ** -0.5,
        "c_im": nrm(ks[14], (DEPTH, N_DIR, G, C, P), f32) * (2.0 * P) ** -0.5,
        "d_skip": nrm(ks[15], (DEPTH, SSM_WIDTH), f32),
        "w_glu": nrm(ks[16], (DEPTH, D_MODEL, D_MODEL), f32) * D_MODEL ** -0.5,
        "b_glu": 0.01 * nrm(ks[17], (DEPTH, D_MODEL), f32),
        "w_out": nrm(ks[18], (DEPTH, D_MODEL, D_MODEL), f32) * D_MODEL ** -0.5,
        "ln2": 1.0 + 0.02 * nrm(ks[19], (DEPTH, D_MODEL), f32),
        "w_up": nrm(ks[20], (DEPTH, D_MODEL, D_FF), f32) * D_MODEL ** -0.5,
        "w_down": nrm(ks[21], (DEPTH, D_FF, D_MODEL), f32) * D_FF ** -0.5,
    }


def reference(x_prompt, x_sample, rel_table, ln1, w_in, q_gain, k_gain, sink, lam_re, lam_im,
              log_dt, b_re, b_im, c_re, c_im, d_skip, w_glu, b_glu, w_out, ln2, w_up, w_down):
    y_prompt = trunk(x_prompt, rel_table, ln1, w_in, q_gain, k_gain, sink, lam_re, lam_im,
                     log_dt, b_re, b_im, c_re, c_im, d_skip, w_glu, b_glu, w_out, ln2,
                     w_up, w_down)
    y_sample = trunk(x_sample, rel_table, ln1, w_in, q_gain, k_gain, sink, lam_re, lam_im,
                     log_dt, b_re, b_im, c_re, c_im, d_skip, w_glu, b_glu, w_out, ln2,
                     w_up, w_down)
    return (y_prompt, y_sample)
```

```cpp
#include <hip/hip_runtime.h>
#include <hip/hip_cooperative_groups.h>
#include <cstdio>
#include <cstdint>
namespace cg = cooperative_groups;
namespace pg8 {
#define PG8_LAS __attribute__((address_space(3)))
typedef unsigned short bf16_t;
typedef short bf16x8 __attribute__((ext_vector_type(8)));
typedef float f32x4 __attribute__((ext_vector_type(4)));
typedef unsigned u32x4 __attribute__((ext_vector_type(4)));
constexpr int BM = 256, BK = 64, HALF = 128, HTB = HALF * BK * 2  , STAGE_BYTES = 8 * HTB, NXCD = 8, WGM = 8;

__host__ __device__ __forceinline__ int lds_byte(int r, int c) { const int st = (r >> 4) * 2 + (c >> 5), rr = r & 15, cc = c & 31, ob = rr * 64 + cc * 2; return st * 1024 + (ob ^ (((ob >> 9) & 1) << 5)); }
__host__ __device__ __forceinline__ void stage_rc(int b, int& R, int& C) { const int st = b / 1024, sb = b % 1024, swz = sb ^ (((sb >> 9) & 1) << 5); R = (st >> 1) * 16 + swz / 64; C = (st & 1) * 32 + (swz % 64) / 2; }
__host__ __device__ __forceinline__ int perm32(int rho) { const int n = rho >> 4, i = rho & 15; return 8 * (i >> 2) + 4 * n + (i & 3); }

struct Unit { int pm, pn; };
struct Gemm { const bf16_t* A; const bf16_t* Bt; int M, N, K; };

struct StaticOrder {
    int nM, nN, nwg, G, c;
    __host__ __device__ void init(int M, int N, int G_, int c_) { nM = M / BM; nN = N / BM; nwg = nM * nN; G = G_; c = c_; }
    __host__ __device__ bool next(int i, Unit& u) const {
        const long L = (long)i * G + c; if (L >= nwg) return false;
        int wgid = (int)L; { const int q = nwg / NXCD, r = nwg % NXCD, xcd = wgid % NXCD, off = wgid / NXCD; wgid = (xcd < r ? xcd * (q + 1) : r * (q + 1) + (xcd - r) * q) + off; }
        const int nig = WGM * nN, gid = wgid / nig, fm = gid * WGM, gsz = (nM - fm) < WGM ? (nM - fm) : WGM;
        u.pm = fm + ((wgid % nig) % gsz); u.pn = (wgid % nig) / gsz; return true;
    }
    __device__ __forceinline__ void a_ready(const Unit&) const {}
    __device__ __forceinline__ void done(const Unit&) const {}
};
__device__ __forceinline__ unsigned cvt_pk_bf16(float lo, float hi) { unsigned r; asm volatile("v_cvt_pk_bf16_f32 %0, %1, %2" : "=v"(r) : "v"(lo), "v"(hi)); return r; }
typedef float f32x2 __attribute__((ext_vector_type(2)));
template <class Epi, class Sched, bool ALIGN_EPI = false, bool SP2 = false>
__device__ __forceinline__ void gemm_phase(PG8_LAS unsigned char* lds, const Gemm g, const Sched& S, const Epi& E) {
    const int tid = threadIdx.x, wid = __builtin_amdgcn_readfirstlane(tid >> 6), lane = tid & 63, wr = wid >> 2, wc = wid & 3, fr = lane & 15, fq = lane >> 4;
    const int K = g.K, nt = K / BK;
    unsigned voffA[2], voffB[2];
#pragma unroll
    for (int i = 0; i < 2; ++i) { int R, C; stage_rc(tid * 16 + i * 8192, R, C); const int Rb = Epi::PERM ? ((R & ~31) + perm32(R & 31)) : R;
        voffA[i] = (unsigned)(R * K + C) * 2u; voffB[i] = (unsigned)(Rb * K + C) * 2u; }
    const size_t kstep = (size_t)(BK * 2);
    const size_t hstep = (size_t)HALF * K * 2;
    const size_t tstep = 2 * hstep;
    const unsigned ldsw = (unsigned)wid * 1024u;
    const int aoff = lds_byte(wr * 64 + fr, fq * 8), boff = lds_byte(wc * 32 + fr, fq * 8);
#define PG8_SA(b, h) (((b) * 2 + (h)) * HTB)
#define PG8_SB(b, h) ((4 + (b) * 2 + (h)) * HTB)
#define PG8_STAGE(bufoff, gbase, voff) do { _Pragma("unroll") for (int _i = 0; _i < 2; ++_i) \
        __builtin_amdgcn_global_load_lds((const unsigned*)((const char*)(gbase) + (voff)[_i]), (PG8_LAS unsigned*)(lds + (bufoff) + ldsw + _i * 8192), 16, 0, 0); } while (0)
#define PG8_LDA(dst, b, h) do { _Pragma("unroll") for (int m = 0; m < 4; ++m) _Pragma("unroll") for (int k = 0; k < 2; ++k) dst[m][k] = *(const PG8_LAS bf16x8*)(lds + PG8_SA(b, h) + aoff + m * 2048 + k * 1024); } while (0)
#define PG8_LDB(dst, b, h) do { _Pragma("unroll") for (int n = 0; n < 2; ++n) _Pragma("unroll") for (int k = 0; k < 2; ++k) dst[n][k] = *(const PG8_LAS bf16x8*)(lds + PG8_SB(b, h) + boff + n * 2048 + k * 1024); } while (0)
#define PG8_MMA(ai, bj, At, Bt) do { __builtin_amdgcn_s_setprio(1); _Pragma("unroll") for (int m = 0; m < 4; ++m) _Pragma("unroll") for (int n = 0; n < 2; ++n) _Pragma("unroll") for (int k = 0; k < 2; ++k) \
        acc[ai][bj][m][n] = __builtin_amdgcn_mfma_f32_16x16x32_bf16(Bt[n][k], At[m][k], acc[ai][bj][m][n], 0, 0, 0); __builtin_amdgcn_s_setprio(0); } while (0)
#define PG8_WAIT_V(n) asm volatile("s_waitcnt vmcnt(" #n ")" ::: "memory")
#define PG8_WAIT_L(n) asm volatile("s_waitcnt lgkmcnt(" #n ")" ::: "memory")
#define PG8_BAR __builtin_amdgcn_s_barrier()
#define PG8_SCHED __builtin_amdgcn_sched_barrier(0)
    Unit cur, nxt; int ui = 0;
    if (!S.next(0, cur)) return;
    f32x4 acc[2][2][4][2];
#pragma unroll
    for (int a = 0; a < 2; ++a)
#pragma unroll
        for (int b = 0; b < 2; ++b)
#pragma unroll
            for (int m = 0; m < 4; ++m)
#pragma unroll
                for (int n = 0; n < 2; ++n) acc[a][b][m][n] = (f32x4){0.f, 0.f, 0.f, 0.f};
    bf16x8 At[4][2], B0[2][2], B1[2][2];
    const char* cA = (const char*)g.A + (size_t)cur.pm * tstep; const char* cB = (const char*)g.Bt + (size_t)cur.pn * tstep;
    S.a_ready(cur);
    if constexpr (SP2) {
        PG8_STAGE(PG8_SB(0, 0), cB, voffB); PG8_STAGE(PG8_SB(0, 1), cB + hstep, voffB); PG8_STAGE(PG8_SA(0, 0), cA, voffA); PG8_STAGE(PG8_SA(0, 1), cA + hstep, voffA);
        if (wr == 1) PG8_BAR;
        PG8_WAIT_V(2); PG8_BAR;
        PG8_STAGE(PG8_SB(1, 0), cB + kstep, voffB); PG8_STAGE(PG8_SA(1, 0), cA + kstep, voffA); PG8_STAGE(PG8_SB(1, 1), cB + hstep + kstep, voffB);
        PG8_WAIT_V(6); PG8_BAR;
    } else {
        PG8_STAGE(PG8_SB(0, 0), cB, voffB); PG8_STAGE(PG8_SA(0, 0), cA, voffA); PG8_STAGE(PG8_SB(0, 1), cB + hstep, voffB); PG8_STAGE(PG8_SA(0, 1), cA + hstep, voffA);
        if (wr == 1) PG8_BAR;
        PG8_WAIT_V(4); PG8_BAR;
        PG8_STAGE(PG8_SB(1, 0), cB + kstep, voffB); PG8_STAGE(PG8_SA(1, 0), cA + kstep, voffA); PG8_STAGE(PG8_SB(1, 1), cB + hstep + kstep, voffB);
        PG8_WAIT_V(6); PG8_BAR;
    }
    for (;;) {
        const bool has_next = S.next(ui + 1, nxt);
        const char* nA = has_next ? (const char*)g.A + (size_t)nxt.pm * tstep : cA; const char* nB = has_next ? (const char*)g.Bt + (size_t)nxt.pn * tstep : cB;
        for (int t = 0; t < nt; t += 2) {
            const bool last = (t == nt - 2);
            const char* a1 = cA + (size_t)(t + 1) * kstep;
            const char* a2 = last ? nA : cA + (size_t)(t + 2) * kstep; const char* b2 = last ? nB : cB + (size_t)(t + 2) * kstep;
            const char* a3 = a2 + kstep; const char* b3 = b2 + kstep;
            if (last && has_next) S.a_ready(nxt);
            if constexpr (SP2) {
            PG8_LDB(B0, 0, 0); PG8_LDB(B1, 0, 1); PG8_SCHED; PG8_LDA(At, 0, 0); PG8_STAGE(PG8_SA(1, 1), a1 + hstep, voffA);
            PG8_WAIT_V(8); PG8_WAIT_L(0); PG8_BAR; PG8_MMA(0, 0, At, B0); PG8_MMA(0, 1, At, B1); PG8_BAR; PG8_SCHED;
            PG8_LDA(At, 0, 1); PG8_STAGE(PG8_SB(0, 0), b2, voffB); PG8_STAGE(PG8_SB(0, 1), b2 + hstep, voffB); PG8_STAGE(PG8_SA(0, 0), a2, voffA);
            PG8_WAIT_V(8); PG8_WAIT_L(0); PG8_BAR; PG8_MMA(1, 0, At, B0); PG8_MMA(1, 1, At, B1); PG8_BAR; PG8_SCHED;
            PG8_LDB(B0, 1, 0); PG8_LDB(B1, 1, 1); PG8_SCHED; PG8_LDA(At, 1, 0); PG8_STAGE(PG8_SA(0, 1), a2 + hstep, voffA);
            PG8_WAIT_V(8); PG8_WAIT_L(0); PG8_BAR; PG8_MMA(0, 0, At, B0); PG8_MMA(0, 1, At, B1); PG8_BAR; PG8_SCHED;
            PG8_LDA(At, 1, 1); PG8_STAGE(PG8_SB(1, 0), b3, voffB); PG8_STAGE(PG8_SB(1, 1), b3 + hstep, voffB); PG8_STAGE(PG8_SA(1, 0), a3, voffA);
            PG8_WAIT_V(8); PG8_WAIT_L(0); PG8_BAR; PG8_MMA(1, 0, At, B0); PG8_MMA(1, 1, At, B1); PG8_BAR; PG8_SCHED;
            } else {
            PG8_LDB(B0, 0, 0); PG8_SCHED; PG8_LDA(At, 0, 0); PG8_STAGE(PG8_SA(1, 1), a1 + hstep, voffA);
            PG8_WAIT_L(8); PG8_BAR; PG8_WAIT_L(0); PG8_MMA(0, 0, At, B0); PG8_BAR; PG8_SCHED;
            PG8_LDB(B1, 0, 1); PG8_STAGE(PG8_SB(0, 0), b2, voffB);
            PG8_BAR; PG8_WAIT_L(0); PG8_MMA(0, 1, At, B1); PG8_BAR;
            PG8_LDA(At, 0, 1); PG8_STAGE(PG8_SA(0, 0), a2, voffA);
            PG8_BAR; PG8_WAIT_L(0); PG8_MMA(1, 0, At, B0); PG8_BAR; PG8_SCHED;
            PG8_STAGE(PG8_SB(0, 1), b2 + hstep, voffB);
            PG8_WAIT_V(6); PG8_BAR; PG8_MMA(1, 1, At, B1); PG8_BAR;
            PG8_LDB(B0, 1, 0); PG8_SCHED; PG8_LDA(At, 1, 0); PG8_STAGE(PG8_SA(0, 1), a2 + hstep, voffA);
            PG8_WAIT_L(8); PG8_BAR; PG8_WAIT_L(0); PG8_MMA(0, 0, At, B0); PG8_BAR; PG8_SCHED;
            PG8_LDB(B1, 1, 1); PG8_STAGE(PG8_SB(1, 0), b3, voffB);
            PG8_BAR; PG8_WAIT_L(0); PG8_MMA(0, 1, At, B1); PG8_BAR;
            PG8_LDA(At, 1, 1); PG8_STAGE(PG8_SA(1, 0), a3, voffA);
            PG8_BAR; PG8_WAIT_L(0); PG8_MMA(1, 0, At, B0); PG8_BAR; PG8_SCHED;
            PG8_STAGE(PG8_SB(1, 1), b3 + hstep, voffB);
            PG8_WAIT_V(6); PG8_BAR; PG8_MMA(1, 1, At, B1); PG8_BAR;
            }
        }
        if constexpr (ALIGN_EPI) { if (wr == 0) PG8_BAR; }
        if constexpr (!Epi::AFTER_DRAIN) { E(acc, cur, wr, wc, fr, fq); S.done(cur); }
        if (!has_next) break;
#pragma unroll
        for (int a = 0; a < 2; ++a)
#pragma unroll
            for (int b = 0; b < 2; ++b)
#pragma unroll
                for (int m = 0; m < 4; ++m)
#pragma unroll
                    for (int n = 0; n < 2; ++n) acc[a][b][m][n] = (f32x4){0.f, 0.f, 0.f, 0.f};
        cur = nxt; cA = nA; cB = nB; ++ui;
        if constexpr (ALIGN_EPI) { if (wr == 1) PG8_BAR; }
    }
    PG8_WAIT_V(0);
    if constexpr (!ALIGN_EPI) { if (wr == 0) PG8_BAR; }
    PG8_BAR;
    if constexpr (Epi::AFTER_DRAIN) { E.fused(acc, cur, wr, wc, fr, fq, lds, wid, lane); S.done(cur); }
#undef PG8_SA
#undef PG8_SB
#undef PG8_STAGE
#undef PG8_LDA
#undef PG8_LDB
#undef PG8_MMA
#undef PG8_WAIT_V
#undef PG8_WAIT_L
#undef PG8_BAR
#undef PG8_SCHED
}
}

constexpr int D = 1024, NSEQ = 24, L = 4096, M = NSEQ * L, NIN = 4608, FF = 4096, MP = 8 * 4096;
constexpr int LDQ = 1536;
constexpr int LDG = 2048;
constexpr float EPS = 1e-6f, LOG2E = 1.4426950408889634f;
constexpr size_t MiB = 1u << 20;
constexpr size_t OFF_SS2 = 0, OFF_M0 = 393216, OFF_AP = 524288, OFF_AT = 589824, OFF_AT16 = 655360, OFF_BB = 720896, OFF_CF = 1245184;
constexpr size_t OFF_WIN = 2 * MiB, OFF_WGLU = 11 * MiB, OFF_WOUT = 13 * MiB, OFF_WUP = 15 * MiB, OFF_WDN = 23 * MiB;
constexpr size_t OFF_Y = 40 * MiB, OFF_XB = 232 * MiB, OFF_QKVU = 424 * MiB, OFF_UG = 712 * MiB, OFF_BBA = 31 * MiB, OFF_CAF = 31 * MiB + 524288, OFF_K0 = 32 * MiB, OFF_UP = 232 * MiB, WS_NEED = 1000 * MiB;
constexpr int LDS_BYTES = 147456;
#ifndef REPMASK
#define REPMASK 0
#endif
#define REPS(k) (((REPMASK >> (k)) & 1) ? 2 : 1)

typedef unsigned short bf16;
typedef short bf16x8 __attribute__((ext_vector_type(8)));
typedef short s16x4 __attribute__((ext_vector_type(4)));
typedef float f32x4 __attribute__((ext_vector_type(4)));
typedef float f32x2 __attribute__((ext_vector_type(2)));
typedef unsigned u32x4 __attribute__((ext_vector_type(4)));
typedef unsigned u32x2 __attribute__((ext_vector_type(2)));

__device__ __forceinline__ unsigned f2bf(float f) { unsigned u = __builtin_bit_cast(unsigned, f); return (u + 0x7fffu + ((u >> 16) & 1u)) >> 16; }
typedef __bf16 bf16x2_t __attribute__((ext_vector_type(2)));
__device__ __forceinline__ unsigned pk2(float lo, float hi) { const f32x2 v = {lo, hi}; const bf16x2_t b = __builtin_convertvector(v, bf16x2_t); return __builtin_bit_cast(unsigned, b); }
__device__ __forceinline__ unsigned pk2v(f32x2 v) { const bf16x2_t b = __builtin_convertvector(v, bf16x2_t); return __builtin_bit_cast(unsigned, b); }
__device__ __forceinline__ float bflo(unsigned w) { return __builtin_bit_cast(float, w << 16); }
__device__ __forceinline__ float bfhi(unsigned w) { return __builtin_bit_cast(float, w & 0xffff0000u); }
__device__ __forceinline__ float fsigmoid(float x) { return __builtin_amdgcn_rcpf(1.0f + __builtin_amdgcn_exp2f(-LOG2E * x)); }
__device__ __forceinline__ float wave_sum(float v) {
#pragma unroll
    for (int o = 1; o < 64; o <<= 1) v += __shfl_xor(v, o);
    return v;
}

struct Params {
    const float *xp, *xs, *rel_table, *ln1, *w_in, *q_gain, *k_gain, *sink, *lam_re, *lam_im, *log_dt, *b_re, *b_im, *c_re, *c_im, *d_skip, *w_glu, *b_glu, *w_out, *ln2, *w_up, *w_down;
    float* out; unsigned char* ws; int ph_lo, ph_hi;
};

using pg8::Unit; using pg8::HALF; using pg8::BM;
struct EpiProj {
    static constexpr bool PERM = true, AFTER_DRAIN = false;
    bf16* QKV; bf16* UG; bf16* GATES;
    __device__ __forceinline__ void operator()(const f32x4 (&acc)[2][2][4][2], const Unit& u, int wr, int wc, int fr, int fq) const {
        const int row0 = u.pm * BM + wr * 64 + fr, col0 = wc * 32 + 8 * fq;
        if (u.pn >= 6 && u.pn < 10) {
            const int c0 = (u.pn - 6) * 256 + col0;
#pragma unroll
            for (int ai = 0; ai < 2; ++ai)
#pragma unroll
                for (int m = 0; m < 4; ++m) { const size_t row = (size_t)(row0 + ai * HALF + m * 16);
#pragma unroll
                    for (int bj = 0; bj < 2; ++bj) { const int c = c0 + bj * HALF; const f32x4 v0 = acc[ai][bj][m][0], v1 = acc[ai][bj][m][1];
                        u32x4 w; w.x = pk2(v0[0], v0[1]); w.y = pk2(v0[2], v0[3]); w.z = pk2(v1[0], v1[1]); w.w = pk2(v1[2], v1[3]);
                        *(u32x4*)(UG + ((size_t)(c >> 4) * M + row) * 16 + (c & 15)) = w; } }
            return;
        }
        const bool gate = u.pn >= 10;
        bf16* base = gate ? GATES + (u.pn - 10) * 256 : QKV + u.pn * 256;
        const int ldc = gate ? LDG : LDQ;
#pragma unroll
        for (int ai = 0; ai < 2; ++ai)
#pragma unroll
            for (int m = 0; m < 4; ++m) { bf16* rowp = base + (size_t)(row0 + ai * HALF + m * 16) * ldc + col0;
#pragma unroll
                for (int bj = 0; bj < 2; ++bj) { f32x4 v0 = acc[ai][bj][m][0], v1 = acc[ai][bj][m][1];
                    if (gate) {
#pragma unroll
                        for (int e = 0; e < 4; ++e) { v0[e] = fsigmoid(v0[e]); v1[e] = fsigmoid(v1[e]); } }
                    u32x4 w; w.x = pk2(v0[0], v0[1]); w.y = pk2(v0[2], v0[3]); w.z = pk2(v1[0], v1[1]); w.w = pk2(v1[2], v1[3]);
                    *(u32x4*)(rowp + bj * HALF) = w; } }
    }
};
struct EpiGlu {
    static constexpr bool PERM = true, AFTER_DRAIN = false;
    const bf16* Y; const bf16* ATTG; const bf16* GS; const float* bglu; bf16* MIXED;
    __device__ __forceinline__ void operator()(const f32x4 (&acc)[2][2][4][2], const Unit& u, int wr, int wc, int fr, int fq) const {
        const int row0 = u.pm * BM + wr * 64 + fr, col0 = u.pn * BM + wc * 32 + 8 * fq;
#pragma unroll
        for (int bj = 0; bj < 2; ++bj) {
            const int col = col0 + bj * HALF;
            const f32x4 b0 = *(const f32x4*)(bglu + col), b1 = *(const f32x4*)(bglu + col + 4);
#pragma unroll
            for (int ai = 0; ai < 2; ++ai) {
                u32x4 yv[4], av[4], gv[4];
#pragma unroll
                for (int m = 0; m < 4; ++m) { const size_t row = (size_t)(row0 + ai * HALF + m * 16);
                    yv[m] = *(const u32x4*)(Y + row * D + col); av[m] = *(const u32x4*)(ATTG + row * LDQ + col); gv[m] = *(const u32x4*)(GS + row * LDG + col); }
#pragma unroll
                for (int m = 0; m < 4; ++m) { const size_t row = (size_t)(row0 + ai * HALF + m * 16);
                    const f32x4 z0 = acc[ai][bj][m][0] + b0, z1 = acc[ai][bj][m][1] + b1;
                    float r[8];
#pragma unroll
                    for (int e = 0; e < 4; ++e) { const float z = e < 2 ? z0[2 * e] : z1[2 * (e - 2)], zz = e < 2 ? z0[2 * e + 1] : z1[2 * (e - 2) + 1];
                        r[2 * e] = bflo(av[m][e]) + bflo(gv[m][e]) * bflo(yv[m][e]) * fsigmoid(z);
                        r[2 * e + 1] = bfhi(av[m][e]) + bfhi(gv[m][e]) * bfhi(yv[m][e]) * fsigmoid(zz); }
                    u32x4 w; w.x = pk2(r[0], r[1]); w.y = pk2(r[2], r[3]); w.z = pk2(r[4], r[5]); w.w = pk2(r[6], r[7]);
                    *(u32x4*)(MIXED + row * D + col) = w; } } }
    }
};
struct EpiOut {
    static constexpr bool PERM = true, AFTER_DRAIN = false;
    const float* xp; const float* xs; float* out; bf16* X1B; float* ss2;
    __device__ __forceinline__ void operator()(const f32x4 (&acc)[2][2][4][2], const Unit& u, int wr, int wc, int fr, int fq) const {
        const int row0 = u.pm * BM + wr * 64 + fr, col0 = u.pn * BM + wc * 32 + 8 * fq;
        const float* xb = (u.pm * BM < MP) ? xp : xs - (size_t)MP * D;
#pragma unroll
        for (int ai = 0; ai < 2; ++ai)
#pragma unroll
            for (int mh = 0; mh < 2; ++mh) {
                f32x4 xv[2][2][2];
#pragma unroll
                for (int mm = 0; mm < 2; ++mm)
#pragma unroll
                    for (int bj = 0; bj < 2; ++bj) { const size_t off = (size_t)(row0 + ai * HALF + (2 * mh + mm) * 16) * D + col0 + bj * HALF;
                        xv[mm][bj][0] = *(const f32x4*)(xb + off); xv[mm][bj][1] = *(const f32x4*)(xb + off + 4); }
#pragma unroll
                for (int mm = 0; mm < 2; ++mm) { const int m = 2 * mh + mm; const size_t row = (size_t)(row0 + ai * HALF + m * 16); float ssq = 0.f;
#pragma unroll
                    for (int bj = 0; bj < 2; ++bj) { const size_t off = row * D + col0 + bj * HALF;
                        const f32x4 v0 = acc[ai][bj][m][0] + xv[mm][bj][0], v1 = acc[ai][bj][m][1] + xv[mm][bj][1];
                        *(f32x4*)(out + off) = v0; *(f32x4*)(out + off + 4) = v1;
                        ssq += (v0[0] * v0[0] + v0[1] * v0[1]) + (v0[2] * v0[2] + v0[3] * v0[3]) + (v1[0] * v1[0] + v1[1] * v1[1]) + (v1[2] * v1[2] + v1[3] * v1[3]);
                        u32x4 w; w.x = pk2(v0[0], v0[1]); w.y = pk2(v0[2], v0[3]); w.z = pk2(v1[0], v1[1]); w.w = pk2(v1[2], v1[3]);
                        *(u32x4*)(X1B + off) = w; }
                    ssq += __shfl_xor(ssq, 16); ssq += __shfl_xor(ssq, 32);
                    if (fq == 0) atomicAdd(ss2 + row, ssq); } }
    }
};
struct EpiUp {
    static constexpr bool PERM = true, AFTER_DRAIN = false;
    const float* ss2; bf16* UP;
    __device__ __forceinline__ void operator()(const f32x4 (&acc)[2][2][4][2], const Unit& u, int wr, int wc, int fr, int fq) const {
        const int row0 = u.pm * BM + wr * 64 + fr, col0 = u.pn * BM + wc * 32 + 8 * fq;
#pragma unroll
        for (int ai = 0; ai < 2; ++ai)
#pragma unroll
            for (int m = 0; m < 4; ++m) { const size_t row = (size_t)(row0 + ai * HALF + m * 16);
                const float r2 = __builtin_amdgcn_rsqf(ss2[row] * (1.0f / D) + EPS);
#pragma unroll
                for (int bj = 0; bj < 2; ++bj) { f32x4 v0 = acc[ai][bj][m][0] * r2, v1 = acc[ai][bj][m][1] * r2;
#pragma unroll
                    for (int e = 0; e < 4; ++e) { const float a = fmaxf(v0[e], 0.f), b = fmaxf(v1[e], 0.f); v0[e] = a * a; v1[e] = b * b; }
                    u32x4 w; w.x = pk2(v0[0], v0[1]); w.y = pk2(v0[2], v0[3]); w.z = pk2(v1[0], v1[1]); w.w = pk2(v1[2], v1[3]);
                    *(u32x4*)(UP + row * FF + col0 + bj * HALF) = w; } }
    }
};
struct EpiDown {
    static constexpr bool PERM = true, AFTER_DRAIN = false;
    float* out;
    __device__ __forceinline__ void operator()(const f32x4 (&acc)[2][2][4][2], const Unit& u, int wr, int wc, int fr, int fq) const {
        const int row0 = u.pm * BM + wr * 64 + fr, col0 = u.pn * BM + wc * 32 + 8 * fq;
#pragma unroll
        for (int ai = 0; ai < 2; ++ai)
#pragma unroll
            for (int mh = 0; mh < 2; ++mh) {
                f32x4 xv[2][2][2];
#pragma unroll
                for (int mm = 0; mm < 2; ++mm)
#pragma unroll
                    for (int bj = 0; bj < 2; ++bj) { const float* p = out + (size_t)(row0 + ai * HALF + (2 * mh + mm) * 16) * D + col0 + bj * HALF; xv[mm][bj][0] = *(const f32x4*)p; xv[mm][bj][1] = *(const f32x4*)(p + 4); }
#pragma unroll
                for (int mm = 0; mm < 2; ++mm)
#pragma unroll
                    for (int bj = 0; bj < 2; ++bj) { const int m = 2 * mh + mm; float* p = out + (size_t)(row0 + ai * HALF + m * 16) * D + col0 + bj * HALF;
                        *(f32x4*)p = acc[ai][bj][m][0] + xv[mm][bj][0]; *(f32x4*)(p + 4) = acc[ai][bj][m][1] + xv[mm][bj][1]; } }
    }
};

__device__ __forceinline__ void transpose_item(const float* W, int K, int N, bf16* WT, const float* kscale, float* scr, int item, int lane) {
    const int nblk = N / 32, kb = item / nblk, nb = item % nblk, k0 = 64 * kb, n0 = 32 * nb;
    float tv[32];
#pragma unroll
    for (int i = 0; i < 32; ++i) tv[i] = W[(size_t)(k0 + 2 * i + (lane >> 5)) * N + n0 + (lane & 31)];
#pragma unroll
    for (int i = 0; i < 32; ++i) { const int kk = 2 * i + (lane >> 5); float v = tv[i]; if (kscale) v *= kscale[k0 + kk]; scr[kk * 33 + (lane & 31)] = v; }
    asm volatile("s_waitcnt lgkmcnt(0)" ::: "memory");
    const int c = lane & 7;
#pragma unroll
    for (int j = 0; j < 4; ++j) { const int n = (lane >> 3) + 8 * j; const float* s = scr + (8 * c) * 33 + n;
        u32x4 o; o.x = pk2(s[0 * 33], s[1 * 33]); o.y = pk2(s[2 * 33], s[3 * 33]); o.z = pk2(s[4 * 33], s[5 * 33]); o.w = pk2(s[6 * 33], s[7 * 33]);
        *(u32x4*)(WT + (size_t)(n0 + n) * K + k0 + 8 * c) = o; }
    asm volatile("s_waitcnt lgkmcnt(0)" ::: "memory");
}
__device__ __forceinline__ void sincos_d(double x, double& s, double& c) {
    const double k = __builtin_rint(x * 0.63661977236758134308), r = (x - k * 1.5707963267948966) - k * 6.123233995736766e-17, r2 = r * r;
    double sp = 1.0, cp = 1.0;
#pragma unroll
    for (int i = 10; i >= 1; --i) { sp = 1.0 - sp * r2 / (double)((2 * i) * (2 * i + 1)); cp = 1.0 - cp * r2 / (double)((2 * i - 1) * (2 * i)); }
    sp *= r;
    const int q = ((int)k) & 3;
    s = (q == 0) ? sp : (q == 1) ? cp : (q == 2) ? -sp : -cp;
    c = (q == 0) ? cp : (q == 1) ? -sp : (q == 2) ? -cp : sp;
}
__device__ __forceinline__ void ssm_disc(const Params& P, int dg, int p, double& are, double& aim, double& cre, double& cim) {
    const double dt = exp((double)P.log_dt[dg]);
    const double lr = (double)P.lam_re[dg * 64 + p], li = (double)P.lam_im[dg * 64 + p];
    const double mag = exp(lr * dt); double sn, cs; sincos_d(li * dt, sn, cs);
    are = mag * cs; aim = mag * sn;
    const double den = lr * lr + li * li, nr = are - 1.0, ni = aim;
    cre = (nr * lr + ni * li) / den; cim = (ni * lr - nr * li) / den;
}
__device__ __forceinline__ void ssm_prep(const Params& P, int dg, int lane, float* scr) {
    unsigned char* ws = P.ws;
    const int p = lane;
    double are, aim, cre, cim; ssm_disc(P, dg, p, are, aim, cre, cim);
    ((f32x2*)(ws + OFF_AP))[dg * 64 + p] = (f32x2){(float)are, (float)aim};
    double pr = are, pi = aim;
#pragma unroll 1
    for (int i = 0; i < 10; ++i) { const double nr_ = pr * pr - pi * pi, ni_ = 2.0 * pr * pi; pr = nr_; pi = ni_;
        if (i == 5) ((f32x2*)(ws + OFF_AT))[dg * 64 + p] = (f32x2){(float)pr, (float)pi}; }
    ((f32x2*)(ws + OFF_AT16))[dg * 64 + p] = (f32x2){(float)pr, (float)pi};
    bf16* BB = (bf16*)(ws + OFF_BB); bf16* BBA = (bf16*)(ws + OFF_BBA);
#pragma unroll 4
    for (int c = 0; c < 16; ++c) { const double br = (double)P.b_re[(size_t)(dg * 64 + p) * 16 + c], bi = (double)P.b_im[(size_t)(dg * 64 + p) * 16 + c];
        const double bbr = cre * br - cim * bi, bbi = cre * bi + cim * br;
        BB[((size_t)(dg * 2 + 0) * 64 + p) * 16 + c] = (bf16)f2bf((float)bbr);
        BB[((size_t)(dg * 2 + 1) * 64 + p) * 16 + c] = (bf16)f2bf((float)bbi);
        BBA[((size_t)(dg * 2 + 0) * 64 + p) * 16 + c] = (bf16)f2bf((float)(are * bbr - aim * bbi));
        BBA[((size_t)(dg * 2 + 1) * 64 + p) * 16 + c] = (bf16)f2bf((float)(are * bbi + aim * bbr));
        scr[(p * 16 + c) * 2] = (float)bbr; scr[(p * 16 + c) * 2 + 1] = (float)bbi; }
    scr[2048 + 2 * p] = (float)are; scr[2048 + 2 * p + 1] = (float)aim;
    asm volatile("s_waitcnt lgkmcnt(0)" ::: "memory");
    bf16* CF = (bf16*)(ws + OFF_CF); bf16* CAF = (bf16*)(ws + OFF_CAF);
    for (int e = lane; e < 2048; e += 64) { const int jj = e & 7, fq = (e >> 3) & 3, c = (e >> 5) & 15, s = e >> 9;
        const int pp = 16 * (2 * (s & 1) + (jj >> 2)) + 4 * fq + (jj & 3);
        const float v = (s < 2) ? P.c_re[(size_t)(dg * 16 + c) * 64 + pp] : -P.c_im[(size_t)(dg * 16 + c) * 64 + pp];
        CF[(size_t)dg * 2048 + e] = (bf16)f2bf(v);
        const float cr = P.c_re[(size_t)(dg * 16 + c) * 64 + pp], ci = P.c_im[(size_t)(dg * 16 + c) * 64 + pp], ar_ = scr[2048 + 2 * pp], ai_ = scr[2048 + 2 * pp + 1];
        CAF[(size_t)dg * 2048 + e] = (bf16)f2bf((s < 2) ? cr * ar_ - ci * ai_ : -(cr * ai_ + ci * ar_)); }
    bf16* K0 = (bf16*)(ws + OFF_K0);
    { const int co = lane >> 2, cin0 = (lane & 3) * 4; float acc[4] = {0.f, 0.f, 0.f, 0.f};
#pragma unroll 8
        for (int pp = 0; pp < 64; ++pp) { const float cr = P.c_re[(size_t)(dg * 16 + co) * 64 + pp], ci = P.c_im[(size_t)(dg * 16 + co) * 64 + pp];
#pragma unroll
            for (int i = 0; i < 4; ++i) acc[i] += cr * scr[(pp * 16 + cin0 + i) * 2] - ci * scr[(pp * 16 + cin0 + i) * 2 + 1]; }
        *(u32x2*)(K0 + (size_t)dg * 256 + lane * 4) = (u32x2){pk2(acc[0], acc[1]), pk2(acc[2], acc[3])}; }
    asm volatile("s_waitcnt lgkmcnt(0)" ::: "memory");
}
__device__ __forceinline__ void p0_prologue(const Params& P, unsigned char* lds, int tid, int wave, int lane) {
    unsigned char* ws = P.ws;
    float* scr = (float*)(lds + wave * 16384);
    const int gw = blockIdx.x * 8 + wave, NGW = gridDim.x * 8;
    constexpr int I_IN = 16 * (NIN / 32), I_G = 16 * 32, I_UP = 16 * (FF / 32), I_DN = (FF / 64) * 32;
    constexpr int NITEMS = I_IN + 2 * I_G + I_UP + I_DN;
    for (int it = gw; it < NITEMS; it += NGW) {
        int r = it;
        if (r < I_IN) { transpose_item(P.w_in, D, NIN, (bf16*)(ws + OFF_WIN), nullptr, scr, r, lane); continue; } r -= I_IN;
        if (r < I_G) { transpose_item(P.w_glu, D, D, (bf16*)(ws + OFF_WGLU), nullptr, scr, r, lane); continue; } r -= I_G;
        if (r < I_G) { transpose_item(P.w_out, D, D, (bf16*)(ws + OFF_WOUT), nullptr, scr, r, lane); continue; } r -= I_G;
        if (r < I_UP) { transpose_item(P.w_up, D, FF, (bf16*)(ws + OFF_WUP), P.ln2, scr, r, lane); continue; } r -= I_UP;
        transpose_item(P.w_down, FF, D, (bf16*)(ws + OFF_WDN), nullptr, scr, r, lane);
    }
    if (wave == 7) for (int dg = blockIdx.x; dg < 128; dg += gridDim.x) ssm_prep(P, dg, lane, scr);
    if (blockIdx.x == gridDim.x - 1 && wave == 6) {
        float gq = fabsf(P.q_gain[lane]), gk = fabsf(P.k_gain[lane]);
#pragma unroll
        for (int o = 1; o < 64; o <<= 1) { gq = fmaxf(gq, __shfl_xor(gq, o)); gk = fmaxf(gk, __shfl_xor(gk, o)); }
        if (lane < 16) { float bm = 0.f; for (int b = 0; b < 32; ++b) bm = fmaxf(bm, fabsf(P.rel_table[b * 16 + lane]));
            ((float*)(ws + OFF_M0))[lane] = fmaxf((8.0f * gq * gk * 1.0001f + bm) * LOG2E, P.sink[lane] * LOG2E); }
    }
    float* ss2 = (float*)(ws + OFF_SS2);
    for (int i = blockIdx.x * 512 + tid; i < M; i += gridDim.x * 512) ss2[i] = 0.f;
    f32x4 gl[4];
#pragma unroll
    for (int j = 0; j < 4; ++j) gl[j] = ((const f32x4*)P.ln1)[lane + 64 * j];
    bf16* XB = (bf16*)(ws + OFF_XB);
    f32x4 v[4], vn[4], vnn[4];
    auto xrp = [&](int m) { return (const f32x4*)((m < MP) ? P.xp + (size_t)m * D : P.xs + (size_t)(m - MP) * D) + lane; };
    if (gw < M) { const f32x4* xr = xrp(gw);
#pragma unroll
        for (int j = 0; j < 4; ++j) v[j] = xr[64 * j]; }
    if (gw + NGW < M) { const f32x4* xr = xrp(gw + NGW);
#pragma unroll
        for (int j = 0; j < 4; ++j) vn[j] = xr[64 * j]; }
    for (int m = gw; m < M; m += NGW) {
        const int mnn = m + 2 * NGW;
        if (mnn < M) { const f32x4* xr = xrp(mnn);
#pragma unroll
            for (int j = 0; j < 4; ++j) vnn[j] = xr[64 * j]; }
        float s = 0.f;
#pragma unroll
        for (int j = 0; j < 4; ++j) s += (v[j].x * v[j].x + v[j].y * v[j].y) + (v[j].z * v[j].z + v[j].w * v[j].w);
        const float rstd = 1.0f / sqrtf(wave_sum(s) * (1.f / D) + EPS);
        u32x2* o8 = (u32x2*)(XB + (size_t)m * D) + lane;
#pragma unroll
        for (int j = 0; j < 4; ++j) { const f32x4 t = v[j] * rstd * gl[j]; o8[64 * j] = (u32x2){pk2(t.x, t.y), pk2(t.z, t.w)}; }
#pragma unroll
        for (int j = 0; j < 4; ++j) { v[j] = vn[j]; vn[j] = vnn[j]; }
    }
}

constexpr int KST = 72;
constexpr int AT_K = 0, AT_V = 2 * 64 * KST * 2, AT_TB = 4 * 64 * KST * 2, AT_Q = AT_TB + 8192;
__device__ __forceinline__ void attn_phase(const Params& P, unsigned char* lds, int tid_in, int w, int lane_in) {
    bf16* QKVU = (bf16*)(P.ws + OFF_QKVU);
    const bf16* GATES = (const bf16*)P.out;
    const int g = w >> 1, qh = w & 1;
    float* tb = (float*)(lds + AT_TB);
    int tb_kh = -1;
    for (int item = blockIdx.x; item < NSEQ * 32 * 4; item += gridDim.x) {
        int lane = lane_in; asm volatile("" : "+v"(lane));
        const int tid = w * 64 + lane, fr = lane & 15, fq = lane >> 4;
        int kh, n, seq;
        if (gridDim.x == 256) { const int x_ = blockIdx.x & 7, i_ = (item - (int)blockIdx.x) >> 8; kh = x_ & 3; n = blockIdx.x >> 3; seq = 2 * i_ + (x_ >> 2); }
        else { kh = item & 3; n = (item >> 2) & 31; seq = item >> 7; }
        const int h = kh * 4 + g;
        const size_t m0 = (size_t)seq * L + n * 128;
        __syncthreads();
        if (kh != tb_kh) {
            tb_kh = kh;
            for (int e = tid; e < 4 * 512; e += 512) { const int gg = e >> 9, idx = e & 511, rel = idx - 255; float v = -1e30f;
                if (rel >= -128 && rel <= 128) { const int na = rel < 0 ? -rel : rel;
                    int b = na < 8 ? na : 8 + (na >= 12) + (na >= 16) + (na >= 23) + (na >= 32) + (na >= 46) + (na >= 64) + (na >= 91);
                    b += rel > 0 ? 16 : 0; v = P.rel_table[b * 16 + kh * 4 + gg] * LOG2E - ((const float*)(P.ws + OFF_M0))[kh * 4 + gg]; }
                tb[e] = v; }
        }
        const int c_lo = (n == 0) ? 2 : 0, c_hi = (n == 31) ? 4 : 6;
        u32x4 kreg, vreg;
        auto gload = [&](int c) {
            const size_t mk = m0 - 128 + 64 * c;
            kreg = *(const u32x4*)(QKVU + (mk + (tid >> 3)) * LDQ + 1024 + kh * 64 + 8 * (tid & 7));
            vreg = *(const u32x4*)(QKVU + (mk + lane) * LDQ + 1280 + kh * 64 + 8 * w);
        };
        bf16x8* Qs = (bf16x8*)(lds + AT_Q + w * 8192) + lane;
#pragma unroll
        for (int qg = 0; qg < 4; ++qg)
#pragma unroll
            for (int ks = 0; ks < 2; ++ks)
                __builtin_amdgcn_global_load_lds((const unsigned*)(QKVU + (m0 + 64 * qh + 16 * qg + fr) * LDQ + h * 64 + 32 * ks + 8 * fq),
                                                 (PG8_LAS unsigned*)((PG8_LAS unsigned char*)lds + AT_Q + w * 8192 + (qg * 2 + ks) * 1024), 16, 0, 0);
        gload(c_lo);
        asm volatile("s_waitcnt vmcnt(0)" ::: "memory");
        {
            float gq[2][8];
#pragma unroll
            for (int ks = 0; ks < 2; ++ks)
#pragma unroll
                for (int j = 0; j < 8; ++j) gq[ks][j] = P.q_gain[32 * ks + 8 * fq + j] * (0.125f * LOG2E);
#pragma unroll 1
            for (int qg = 0; qg < 4; ++qg) {
                const u32x4 r0 = __builtin_bit_cast(u32x4, Qs[(qg * 2 + 0) * 64]), r1 = __builtin_bit_cast(u32x4, Qs[(qg * 2 + 1) * 64]);
                float f[2][8]; float ss = 0.f;
#pragma unroll
                for (int e = 0; e < 4; ++e) { f[0][2 * e] = bflo(r0[e]); f[0][2 * e + 1] = bfhi(r0[e]); f[1][2 * e] = bflo(r1[e]); f[1][2 * e + 1] = bfhi(r1[e]); }
#pragma unroll
                for (int j = 0; j < 8; ++j) ss += f[0][j] * f[0][j] + f[1][j] * f[1][j];
                ss += __shfl_xor(ss, 16); ss += __shfl_xor(ss, 32);
                const float rn = 1.0f / sqrtf(ss * (1.f / 64) + EPS);
#pragma unroll
                for (int ks = 0; ks < 2; ++ks) { u32x4 o;
#pragma unroll
                    for (int e = 0; e < 4; ++e) o[e] = pk2(f[ks][2 * e] * rn * gq[ks][2 * e], f[ks][2 * e + 1] * rn * gq[ks][2 * e + 1]);
                    Qs[(qg * 2 + ks) * 64] = __builtin_bit_cast(bf16x8, o); }
            }
        }
        const float sinkp = __builtin_amdgcn_exp2f(P.sink[h] * LOG2E - ((const float*)(P.ws + OFF_M0))[h]);
        f32x4 O[4][4]; float lrow[4];
#pragma unroll
        for (int qg = 0; qg < 4; ++qg) { lrow[qg] = (fq == 0) ? sinkp : 0.f;
#pragma unroll
            for (int dt = 0; dt < 4; ++dt) O[qg][dt] = (f32x4){0.f, 0.f, 0.f, 0.f}; }
        auto lstore = [&](int buf) {
            float f[8]; float ss = 0.f; float gk[8];
#pragma unroll
            for (int j = 0; j < 8; ++j) gk[j] = P.k_gain[8 * (tid & 7) + j];
#pragma unroll
            for (int e = 0; e < 4; ++e) { f[2 * e] = bflo(kreg[e]); f[2 * e + 1] = bfhi(kreg[e]); }
#pragma unroll
            for (int j = 0; j < 8; ++j) ss += f[j] * f[j];
            ss += __shfl_xor(ss, 1); ss += __shfl_xor(ss, 2); ss += __shfl_xor(ss, 4);
            const float rn = 1.0f / sqrtf(ss * (1.f / 64) + EPS);
            u32x4 o;
#pragma unroll
            for (int e = 0; e < 4; ++e) o[e] = pk2(f[2 * e] * rn * gk[2 * e], f[2 * e + 1] * rn * gk[2 * e + 1]);
            *(u32x4*)(lds + AT_K + buf * (64 * KST * 2) + ((tid >> 3) * KST + 8 * (tid & 7)) * 2) = o;
            bf16* vt = (bf16*)(lds + AT_V + buf * (64 * KST * 2));
#pragma unroll
            for (int e = 0; e < 4; ++e) { vt[(8 * w + 2 * e) * KST + lane] = (bf16)(vreg[e] & 0xffffu); vt[(8 * w + 2 * e + 1) * KST + lane] = (bf16)(vreg[e] >> 16); }
        };
        lstore(0);
        __syncthreads();
        for (int c = c_lo; c < c_hi; ++c) {
            const int buf = (c - c_lo) & 1;
            if (c + 1 < c_hi) gload(c + 1);
            const bool skip = (qh == 0 && c == 5) || (qh == 1 && c == 0);
            if (!skip) {
                const unsigned char* kb = lds + AT_K + buf * (64 * KST * 2);
                const unsigned char* vb = lds + AT_V + buf * (64 * KST * 2);
                bf16x8 Kf[4][2];
#pragma unroll
                for (int t = 0; t < 4; ++t)
#pragma unroll
                    for (int ks = 0; ks < 2; ++ks) Kf[t][ks] = *(const bf16x8*)(kb + ((16 * t + fr) * KST + 32 * ks + 8 * fq) * 2);
#pragma unroll
                for (int qg = 0; qg < 4; ++qg) {
                    f32x4 S[4];
                    __builtin_amdgcn_sched_barrier(0);
                    const bf16x8 Qf0 = Qs[(qg * 2 + 0) * 64], Qf1 = Qs[(qg * 2 + 1) * 64];
#pragma unroll
                    for (int t = 0; t < 4; ++t) { S[t] = (f32x4){0.f, 0.f, 0.f, 0.f};
#pragma unroll
                        for (int ks = 0; ks < 2; ++ks) S[t] = __builtin_amdgcn_mfma_f32_16x16x32_bf16(Kf[t][ks], ks == 0 ? Qf0 : Qf1, S[t], 0, 0, 0); }
                    const int q = 64 * qh + 16 * qg + fr;
                    const float* tbp = tb + g * 512 + (64 * c - 128 + 4 * fq - q + 255);
                    float rs = 0.f;
#pragma unroll
                    for (int t = 0; t < 4; ++t)
#pragma unroll
                        for (int j = 0; j < 4; ++j) { S[t][j] = __builtin_amdgcn_exp2f(S[t][j] + tbp[16 * t + j]); rs += S[t][j]; }
                    lrow[qg] += rs;
                    bf16x8 Pf[2];
#pragma unroll
                    for (int s = 0; s < 2; ++s) { u32x4 o; o.x = pk2(S[2 * s][0], S[2 * s][1]); o.y = pk2(S[2 * s][2], S[2 * s][3]); o.z = pk2(S[2 * s + 1][0], S[2 * s + 1][1]); o.w = pk2(S[2 * s + 1][2], S[2 * s + 1][3]);
                        Pf[s] = __builtin_bit_cast(bf16x8, o); }
                    __builtin_amdgcn_sched_barrier(0);
#pragma unroll
                    for (int dt = 0; dt < 4; ++dt)
#pragma unroll
                        for (int s = 0; s < 2; ++s) { const s16x4 lo = *(const s16x4*)(vb + ((16 * dt + fr) * KST + 32 * s + 4 * fq) * 2), hi = *(const s16x4*)(vb + ((16 * dt + fr) * KST + 32 * s + 16 + 4 * fq) * 2);
                            const bf16x8 Vf = (bf16x8){lo[0], lo[1], lo[2], lo[3], hi[0], hi[1], hi[2], hi[3]};
                            O[qg][dt] = __builtin_amdgcn_mfma_f32_16x16x32_bf16(Vf, Pf[s], O[qg][dt], 0, 0, 0); }
                }
            }
            if (c + 1 < c_hi) lstore(buf ^ 1);
            __syncthreads();
        }
        u32x2 gv[4][4];
#pragma unroll
        for (int qg = 0; qg < 4; ++qg)
#pragma unroll
            for (int dt = 0; dt < 4; ++dt) gv[qg][dt] = *(const u32x2*)(GATES + (m0 + 64 * qh + 16 * qg + fr) * LDG + h * 64 + 16 * dt + 4 * fq);
#pragma unroll
        for (int qg = 0; qg < 4; ++qg) {
            float lt = lrow[qg]; lt += __shfl_xor(lt, 16); lt += __shfl_xor(lt, 32);
            const float inv = 1.0f / lt;
            const size_t row = m0 + 64 * qh + 16 * qg + fr;
#pragma unroll
            for (int dt = 0; dt < 4; ++dt) { const int col = h * 64 + 16 * dt + 4 * fq;
                const f32x4 o = O[qg][dt] * inv;
                *(u32x2*)(QKVU + row * LDQ + col) = (u32x2){pk2(o[0] * bflo(gv[qg][dt].x), o[1] * bfhi(gv[qg][dt].x)), pk2(o[2] * bflo(gv[qg][dt].y), o[3] * bfhi(gv[qg][dt].y))}; }
        }
    }
}

constexpr int SS_TOT = 131072;
__device__ __forceinline__ float gelu_tanh(float x) {
    const float t = x + 0.044715f * x * x * x;
    return x * __builtin_amdgcn_rcpf(1.0f + __builtin_amdgcn_exp2f(-2.0f * 0.7978845608028654f * LOG2E * t));
}
__device__ __forceinline__ f32x2 gelu_tanh2(f32x2 x) {
    const f32x2 x2 = x * x, t = x * (x2 * 0.044715f + 1.0f), a = t * (-2.0f * 0.7978845608028654f * LOG2E);
    f32x2 e; e.x = __builtin_amdgcn_exp2f(a.x); e.y = __builtin_amdgcn_exp2f(a.y);
    const f32x2 d = e + 1.0f; f32x2 r; r.x = __builtin_amdgcn_rcpf(d.x); r.y = __builtin_amdgcn_rcpf(d.y);
    return x * r;
}
__device__ __forceinline__ f32x2 cmul(f32x2 a, f32x2 b);
template <int DIR>
__device__ __forceinline__ void ssm_emit(f32x4 y, u32x2 ulo, unsigned long long ybv, f32x4 dsk, u32x2* yp) {
    if (DIR == 1) { *yp = (u32x2){pk2(y[0], y[1]), pk2(y[2], y[3])}; }
    else {
        const unsigned yl = (unsigned)ybv, yh = (unsigned)(ybv >> 32);
        const f32x2 ya = (f32x2){y[0], y[1]} + (f32x2){bflo(yl), bfhi(yl)} + (f32x2){dsk[0], dsk[1]} * (f32x2){bflo(ulo.x), bfhi(ulo.x)};
        const f32x2 yb = (f32x2){y[2], y[3]} + (f32x2){bflo(yh), bfhi(yh)} + (f32x2){dsk[2], dsk[3]} * (f32x2){bflo(ulo.y), bfhi(ulo.y)};
        *yp = (u32x2){pk2v(gelu_tanh2(ya)), pk2v(gelu_tanh2(yb))};
    }
}
template <int DIR, bool OUT>
__device__ __forceinline__ void ssm_pair(const bf16x8 (&Bf2)[4][2], const bf16x8 (&Cf)[4], const bf16x8 (&CAf)[4], s16x4 K0f, const f32x2 (&a2r)[4][2], const f32x2 (&a2i)[4][2],
                                         f32x2 (&hr)[4][2], f32x2 (&hi)[4][2], bf16x8 (&hB)[4], u32x2 u1, u32x2 u2, unsigned long long yb1, unsigned long long yb2, f32x4 dsk, u32x2* yp1, u32x2* yp2) {
    const f32x4 z = (f32x4){0.f, 0.f, 0.f, 0.f};
    f32x4 y1 = z;
    if (OUT) {
        const u32x2 k0_ = __builtin_bit_cast(u32x2, K0f);
        y1 = __builtin_amdgcn_mfma_f32_16x16x32_bf16(__builtin_bit_cast(bf16x8, ((u32x4){k0_.x, k0_.y, 0u, 0u})), __builtin_bit_cast(bf16x8, ((u32x4){u1.x, u1.y, 0u, 0u})), z, 0, 0, 0);
#pragma unroll
        for (int s = 0; s < 4; ++s) y1 = __builtin_amdgcn_mfma_f32_16x16x32_bf16(CAf[s], hB[s], y1, 0, 0, 0); }
    const bf16x8 uB = __builtin_bit_cast(bf16x8, ((u32x4){u1.x, u1.y, u2.x, u2.y}));
#pragma unroll
    for (int pt = 0; pt < 4; ++pt) {
        const f32x4 br = __builtin_amdgcn_mfma_f32_16x16x32_bf16(Bf2[pt][0], uB, z, 0, 0, 0);
        const f32x4 bi = __builtin_amdgcn_mfma_f32_16x16x32_bf16(Bf2[pt][1], uB, z, 0, 0, 0);
#pragma unroll
        for (int jj = 0; jj < 2; ++jj) { const f32x2 brp = (f32x2){br[2 * jj], br[2 * jj + 1]}, bip = (f32x2){bi[2 * jj], bi[2 * jj + 1]}, r0 = hr[pt][jj], i0 = hi[pt][jj];
            hr[pt][jj] = a2r[pt][jj] * r0 - a2i[pt][jj] * i0 + brp;
            hi[pt][jj] = a2r[pt][jj] * i0 + a2i[pt][jj] * r0 + bip; }
    }
    if (!OUT) return;
    ssm_emit<DIR>(y1, u1, yb1, dsk, yp1);
    f32x4 y2 = z;
#pragma unroll
    for (int s = 0; s < 4; ++s) { const int p0 = 2 * (s & 1); u32x4 o;
        if (s < 2) { o.x = pk2v(hr[p0][0]); o.y = pk2v(hr[p0][1]); o.z = pk2v(hr[p0 + 1][0]); o.w = pk2v(hr[p0 + 1][1]); }
        else       { o.x = pk2v(hi[p0][0]); o.y = pk2v(hi[p0][1]); o.z = pk2v(hi[p0 + 1][0]); o.w = pk2v(hi[p0 + 1][1]); }
        hB[s] = __builtin_bit_cast(bf16x8, o);
        y2 = __builtin_amdgcn_mfma_f32_16x16x32_bf16(Cf[s], hB[s], y2, 0, 0, 0); }
    ssm_emit<DIR>(y2, u2, yb2, dsk, yp2);
}
template <int DIR, bool OUT>
__device__ __forceinline__ void ssm_pass2(const Params& P, const bf16* UG, bf16* YP, bf16* Y, f32x2* EP, int seq, int g, int q, int fr_in, int fq_in) {
    int fr = fr_in, fq = fq_in; asm volatile("" : "+v"(fr), "+v"(fq));
    const int dg = DIR * 64 + g;
    const bf16* BB = (const bf16*)(P.ws + OFF_BB); const bf16* BBA = (const bf16*)(P.ws + OFF_BBA); const f32x2* AP = (const f32x2*)(P.ws + OFF_AP);
    const bf16* CF = (const bf16*)(P.ws + OFF_CF); const bf16* CAF = (const bf16*)(P.ws + OFF_CAF); const bf16* K0 = (const bf16*)(P.ws + OFF_K0);
    bf16x8 Bf2[4][2], Cf[4], CAf[4], hB[4]; f32x2 a2r[4][2], a2i[4][2], hr[4][2], hi[4][2];
#pragma unroll
    for (int pt = 0; pt < 4; ++pt) {
#pragma unroll
        for (int ri = 0; ri < 2; ++ri) { const size_t o_ = ((size_t)(dg * 2 + ri) * 64 + 16 * pt + fr) * 16 + 4 * fq; const u32x2 lo = *(const u32x2*)(BBA + o_), hi2 = *(const u32x2*)(BB + o_);
            Bf2[pt][ri] = __builtin_bit_cast(bf16x8, ((u32x4){lo.x, lo.y, hi2.x, hi2.y})); }
#pragma unroll
        for (int jj = 0; jj < 2; ++jj) { const f32x2 a0 = AP[dg * 64 + 16 * pt + 4 * fq + 2 * jj], a1 = AP[dg * 64 + 16 * pt + 4 * fq + 2 * jj + 1], s0 = cmul(a0, a0), s1 = cmul(a1, a1);
            a2r[pt][jj] = (f32x2){s0.x, s1.x}; a2i[pt][jj] = (f32x2){s0.y, s1.y};
            if (OUT) { const f32x2 e0 = EP[DIR * 1024 + (16 * pt + 4 * fq + 2 * jj) * 16 + fr], e1 = EP[DIR * 1024 + (16 * pt + 4 * fq + 2 * jj + 1) * 16 + fr]; hr[pt][jj] = (f32x2){e0.x, e1.x}; hi[pt][jj] = (f32x2){e0.y, e1.y}; }
            else { hr[pt][jj] = (f32x2){0.f, 0.f}; hi[pt][jj] = (f32x2){0.f, 0.f}; } }
    }
#pragma unroll
    for (int s = 0; s < 4; ++s) { if (!OUT) { Cf[s] = (bf16x8){0, 0, 0, 0, 0, 0, 0, 0}; CAf[s] = Cf[s]; hB[s] = Cf[s]; continue; }
        Cf[s] = *(const bf16x8*)(CF + (size_t)dg * 2048 + ((s * 16 + fr) * 4 + fq) * 8); CAf[s] = *(const bf16x8*)(CAF + (size_t)dg * 2048 + ((s * 16 + fr) * 4 + fq) * 8);
        const int p0 = 2 * (s & 1); u32x4 o;
        if (s < 2) { o.x = pk2v(hr[p0][0]); o.y = pk2v(hr[p0][1]); o.z = pk2v(hr[p0 + 1][0]); o.w = pk2v(hr[p0 + 1][1]); }
        else       { o.x = pk2v(hi[p0][0]); o.y = pk2v(hi[p0][1]); o.z = pk2v(hi[p0 + 1][0]); o.w = pk2v(hi[p0 + 1][1]); }
        hB[s] = __builtin_bit_cast(bf16x8, o); }
    s16x4 K0f = (s16x4){0, 0, 0, 0}; if (OUT) K0f = *(const s16x4*)(K0 + (size_t)dg * 256 + fr * 16 + 4 * fq);
    f32x4 dsk = (f32x4){0.f, 0.f, 0.f, 0.f};
    if (OUT && DIR == 0) dsk = *(const f32x4*)(P.d_skip + 16 * g + 4 * fq);
    const size_t rowu = (size_t)seq * L + 64 * 16 * q;
    const bf16* Ub = UG + ((size_t)g * M + rowu) * 16;
    bf16* Pb = YP + ((size_t)g * M + rowu) * 16;
    bf16* Yb = Y + rowu * D + 16 * g;
    const unsigned og = (unsigned)(64 * fr * 16 + 4 * fq) / 4, oy = (unsigned)(64 * fr * D + 4 * fq) / 4;
    constexpr bool NEEDY = OUT && DIR == 0;
    u32x2 bU[2][4]; unsigned long long bY[2][4];
#define TAU(st) (DIR == 0 ? (st) : 63 - (st))
#define SSM_LOAD(B, blk) do { _Pragma("unroll") for (int k_ = 0; k_ < 4; ++k_) { const int tau_ = TAU((blk) * 4 + k_); \
        bU[B][k_] = ((const u32x2*)(Ub + (size_t)tau_ * 16))[og]; \
        if (NEEDY) bY[B][k_] = __hip_atomic_load((const unsigned long long*)(Pb + (size_t)tau_ * 16) + og, __ATOMIC_RELAXED, __HIP_MEMORY_SCOPE_AGENT); } } while (0)
#define YPTR(st) (DIR == 1 ? (u32x2*)(Pb + (size_t)TAU(st) * 16) + og : (u32x2*)(Yb + (size_t)TAU(st) * D) + oy)
#define SSM_PAIRS(B, blk) do { _Pragma("unroll") for (int k_ = 0; k_ < 4; k_ += 2) { const int st_ = (blk) * 4 + k_; __builtin_amdgcn_sched_barrier(0); \
        ssm_pair<DIR, OUT>(Bf2, Cf, CAf, K0f, a2r, a2i, hr, hi, hB, bU[B][k_], bU[B][k_ + 1], NEEDY ? bY[B][k_] : 0ull, NEEDY ? bY[B][k_ + 1] : 0ull, dsk, YPTR(st_), YPTR(st_ + 1)); } } while (0)
    SSM_LOAD(0, 0);
#pragma unroll 1
    for (int b = 0; b < 16; b += 2) {
        SSM_LOAD(1, b + 1);
        __builtin_amdgcn_sched_barrier(0);
        SSM_PAIRS(0, b);
        if (b + 2 < 16) SSM_LOAD(0, b + 2);
        __builtin_amdgcn_sched_barrier(0);
        SSM_PAIRS(1, b + 1);
    }
#undef SSM_LOAD
#undef SSM_PAIRS
#undef YPTR
#undef TAU
    if (!OUT) {
#pragma unroll
        for (int pt = 0; pt < 4; ++pt)
#pragma unroll
            for (int jj = 0; jj < 2; ++jj) { EP[DIR * 1024 + (16 * pt + 4 * fq + 2 * jj) * 16 + fr] = (f32x2){hr[pt][jj].x, hi[pt][jj].x}; EP[DIR * 1024 + (16 * pt + 4 * fq + 2 * jj + 1) * 16 + fr] = (f32x2){hr[pt][jj].y, hi[pt][jj].y}; }
    }
    asm volatile("s_waitcnt vmcnt(0) lgkmcnt(0)" ::: "memory");
}
__device__ __forceinline__ f32x2 cmul(f32x2 a, f32x2 b) { return (f32x2){a.x * b.x - a.y * b.y, a.x * b.y + a.y * b.x}; }
template <int DIR>
__device__ __forceinline__ f32x2 ssm_carry1(f32x2* EPd, f32x2 aT, int lane) {
    f32x2 e[16];
#pragma unroll
    for (int kk = 0; kk < 16; ++kk) e[kk] = EPd[lane * 16 + kk];
    f32x2 acc = (f32x2){0.f, 0.f};
#pragma unroll
    for (int i = 0; i < 16; ++i) { const int kk = DIR == 0 ? i : 15 - i; EPd[lane * 16 + kk] = acc; acc = cmul(aT, acc) + e[kk]; }
    return acc;
}
template <int DIR>
__device__ __forceinline__ void ssm_carry2(f32x2* EPd, f32x2 aT, f32x2 Hq, int lane) {
    f32x2 e[16];
#pragma unroll
    for (int kk = 0; kk < 16; ++kk) e[kk] = EPd[lane * 16 + kk];
    f32x2 pw = Hq;
#pragma unroll
    for (int i = 0; i < 16; ++i) { const int kk = DIR == 0 ? i : 15 - i; EPd[lane * 16 + kk] = e[kk] + pw; pw = cmul(aT, pw); }
}
__device__ __forceinline__ void ssm_phase(const Params& P, unsigned char* lds, int tid, int w, int lane) {
    const bf16* UG = (const bf16*)(P.ws + OFF_UG);
    bf16* Y = (bf16*)(P.ws + OFF_Y); bf16* YP = (bf16*)(P.ws + OFF_XB);
    const int fr = lane & 15, fq = lane >> 4, q = w & 3, ps = w >> 2;
    f32x2* EP = (f32x2*)(lds + w * 16384);
    f32x2* TOT = (f32x2*)(lds + SS_TOT);
    const f32x2* AT = (const f32x2*)(P.ws + OFF_AT); const f32x2* AT16 = (const f32x2*)(P.ws + OFF_AT16);
    for (int couple = blockIdx.x; couple < NSEQ * 64 / 2; couple += gridDim.x) {
        const int pair = couple * 2 + ps, seq = pair >> 6, g = pair & 63;
        __syncthreads();
        for (int rep = 0; rep < REPS(3); ++rep) {
        ssm_pass2<1, false>(P, UG, YP, Y, EP, seq, g, q, fr, fq);
        ssm_pass2<0, false>(P, UG, YP, Y, EP, seq, g, q, fr, fq); }
        const f32x2 aTf = AT[(0 * 64 + g) * 64 + lane], aTb = AT[(1 * 64 + g) * 64 + lane], aT16f = AT16[(0 * 64 + g) * 64 + lane], aT16b = AT16[(1 * 64 + g) * 64 + lane];
        TOT[((ps * 2 + 0) * 4 + q) * 64 + lane] = ssm_carry1<0>(EP, aTf, lane);
        TOT[((ps * 2 + 1) * 4 + q) * 64 + lane] = ssm_carry1<1>(EP + 1024, aTb, lane);
        __syncthreads();
        { f32x2 Hf = (f32x2){0.f, 0.f}, Hb = (f32x2){0.f, 0.f};
            for (int qq = 0; qq < q; ++qq) Hf = cmul(aT16f, Hf) + TOT[((ps * 2 + 0) * 4 + qq) * 64 + lane];
            for (int qq = 3; qq > q; --qq) Hb = cmul(aT16b, Hb) + TOT[((ps * 2 + 1) * 4 + qq) * 64 + lane];
            ssm_carry2<0>(EP, aTf, Hf, lane); ssm_carry2<1>(EP + 1024, aTb, Hb, lane); }
        asm volatile("s_waitcnt lgkmcnt(0)" ::: "memory");
        ssm_pass2<1, true>(P, UG, YP, Y, EP, seq, g, q, fr, fq);
        ssm_pass2<0, true>(P, UG, YP, Y, EP, seq, g, q, fr, fq);
    }
}

#define LAS __attribute__((address_space(3)))
constexpr size_t OFF_BAR = 458752;
constexpr int LDS_MISC_OFF = LDS_BYTES - 16;
#define XB_TMO      128
#define XB_XCNT(j)  (256  + 64 * (j))
#define XB_XSUB(j)  (1280 + 64 * (j))
#define XB_XGEN(j)  (2304 + 64 * (j))
#define XB_TOP      3328
#define XB_TOPGEN   3392
#define XCD_BAR_WORDS 3456
#define XB_SPIN_CAP (1u << 18)

__device__ __forceinline__ unsigned xb_ld(unsigned* p)              { return __hip_atomic_load(p, __ATOMIC_RELAXED, __HIP_MEMORY_SCOPE_AGENT); }
__device__ __forceinline__ unsigned xb_add(unsigned* p, unsigned v) { return __hip_atomic_fetch_add(p, v, __ATOMIC_RELAXED, __HIP_MEMORY_SCOPE_AGENT); }
__device__ __forceinline__ unsigned xb_xcc_id() { return (unsigned)__builtin_amdgcn_s_getreg((3 << 11) | 20) & 0xFu; }
#define XB_SPIN(cond, bar) do { unsigned _sp = 0; while (cond) { __builtin_amdgcn_s_sleep(1); \
    if ((++_sp & 255u) == 0u) { if (xb_ld(&(bar)[XB_TMO])) break; if (_sp > XB_SPIN_CAP) { atomicAdd(&(bar)[XB_TMO], 1u); break; } } } } while (0)

struct XcdBarrier {
    unsigned* bar; unsigned x;
    volatile LAS unsigned* st;
};

__device__ __forceinline__ XcdBarrier xcd_barrier_post(unsigned* bar, volatile LAS unsigned* st) {
    XcdBarrier b; b.bar = bar; b.x = xb_xcc_id(); b.st = st;
    if (threadIdx.x == 0) (void)xb_add(&bar[XB_XCNT(b.x)], 1u);
    return b;
}
__device__ __forceinline__ void xcd_barrier_complete(unsigned* bar, unsigned x, unsigned& nloc, unsigned& nx) {
    const unsigned G = gridDim.x * gridDim.y * gridDim.z;
    unsigned sum, cnt, mine, sp = 0u;
    for (;;) {
        sum = 0u; cnt = 0u; mine = 0u;
#pragma unroll
        for (unsigned j = 0; j < 16; ++j) { const unsigned c = xb_ld(&bar[XB_XCNT(j)]); sum += c; cnt += (c > 0u) ? 1u : 0u; mine = (j == x) ? c : mine; }
        if (sum == G) break;
        __builtin_amdgcn_s_sleep(1);
        if ((++sp & 255u) == 0u) { if (xb_ld(&bar[XB_TMO])) break; if (sp > XB_SPIN_CAP) { atomicAdd(&bar[XB_TMO], 1u); break; } }
    }
    nloc = mine > 0u ? mine : 1u; nx = cnt > 0u ? cnt : 1u;
}

__device__ __forceinline__ void xcd_barrier(const XcdBarrier& b) {
    asm volatile("s_waitcnt vmcnt(0)" ::: "memory");
    __syncthreads();
    if (threadIdx.x == 0) {
        unsigned* bar = b.bar;
        __builtin_amdgcn_s_waitcnt(0);
        unsigned nloc = b.st[0], nx = b.st[1];
        if (nloc == 0u) { xcd_barrier_complete(bar, b.x, nloc, nx); b.st[0] = nloc; b.st[1] = nx; }
        const unsigned old = xb_add(&bar[XB_XSUB(b.x)], 1u);
        const unsigned gen = old / nloc;
        if (old + 1u == (gen + 1u) * nloc) {
            __builtin_amdgcn_fence(__ATOMIC_RELEASE, "agent");
            asm volatile("s_waitcnt vmcnt(0)" ::: "memory");
            const unsigned og = xb_add(&bar[XB_TOP], 1u);
            const unsigned tg = og / nx;
            if (og + 1u == (tg + 1u) * nx) xb_add(&bar[XB_TOPGEN], 1u);
            else XB_SPIN(xb_ld(&bar[XB_TOPGEN]) == tg, bar);
            __builtin_amdgcn_fence(__ATOMIC_ACQUIRE, "agent");
            xb_add(&bar[XB_XGEN(b.x)], 1u);
            asm volatile("s_waitcnt vmcnt(0)" ::: "memory");
        } else {
            XB_SPIN(xb_ld(&bar[XB_XGEN(b.x)]) == gen, bar);
            __builtin_amdgcn_fence(__ATOMIC_ACQUIRE, "agent");
            asm volatile("s_waitcnt vmcnt(0)" ::: "memory");
        }
    }
    __syncthreads();
}

__global__ void __launch_bounds__(512, 2) fwd_megakernel(Params P) {
    extern __shared__ __attribute__((aligned(16))) unsigned char lds[];
    cg::grid_group grid = cg::this_grid();
    const int tid = threadIdx.x, lane = tid & 63, wave = __builtin_amdgcn_readfirstlane(tid >> 6);
    unsigned char* ws = P.ws;
    const int lo = P.ph_lo, hi = P.ph_hi;
#ifndef PHMASK
#define PHMASK 255
#endif
#define IN(k) (((PHMASK >> (k)) & 1) && lo <= (k) && (k) < hi)
#define SEAM(k) do { if (IN(k) && IN((k) + 1)) xcd_barrier(bar); } while (0)
    volatile LAS unsigned* MISC = (volatile LAS unsigned*)((LAS unsigned char*)lds + LDS_MISC_OFF);
    if (tid < 2) MISC[tid] = 0u;
    __syncthreads();
    const XcdBarrier bar = xcd_barrier_post((unsigned*)(ws + OFF_BAR), MISC);
    if (hi < 0) grid.sync();
    PG8_LAS unsigned char* ring = (PG8_LAS unsigned char*)lds;
    bf16* XB = (bf16*)(ws + OFF_XB); bf16* QKVU = (bf16*)(ws + OFF_QKVU); bf16* Y = (bf16*)(ws + OFF_Y); bf16* UPB = (bf16*)(ws + OFF_UP);
    bf16* GATES = (bf16*)P.out; float* ss2 = (float*)(ws + OFF_SS2);
    if (IN(0)) { for (int rep = 0; rep < REPS(0); ++rep) { p0_prologue(P, lds, tid, wave, lane); __syncthreads(); } }
    SEAM(0);
#ifdef EXTRA_SYNCS
    for (int i_ = 0; i_ < EXTRA_SYNCS; ++i_) xcd_barrier(bar);
#endif
    if (IN(1)) {
        pg8::Gemm gm{XB, (const bf16*)(ws + OFF_WIN), M, NIN, D}; pg8::StaticOrder S; S.init(M, NIN, gridDim.x, (int)blockIdx.x);
        EpiProj E{QKVU, (bf16*)(ws + OFF_UG), GATES};
        for (int rep = 0; rep < REPS(1); ++rep)
        pg8::gemm_phase<EpiProj, pg8::StaticOrder, true, true>(ring, gm, S, E);
    }
    SEAM(1);
    if (IN(2)) {
        attn_phase(P, lds, tid, wave, lane); __syncthreads();
        for (int rep = 0; rep < REPS(2); ++rep) ssm_phase(P, lds, tid, wave, lane);
    }
    SEAM(2);
    if (IN(4)) {
        pg8::Gemm gm{Y, (const bf16*)(ws + OFF_WGLU), M, D, D}; pg8::StaticOrder S; S.init(M, D, gridDim.x, (int)blockIdx.x);
        EpiGlu E{Y, QKVU, GATES + 1024, P.b_glu, XB};
        for (int rep = 0; rep < REPS(4); ++rep)
        pg8::gemm_phase<EpiGlu, pg8::StaticOrder, true, true>(ring, gm, S, E);
    }
    SEAM(4);
    if (IN(5)) {
        pg8::Gemm gm{XB, (const bf16*)(ws + OFF_WOUT), M, D, D}; pg8::StaticOrder S; S.init(M, D, gridDim.x, (int)blockIdx.x);
        EpiOut E{P.xp, P.xs, P.out, Y, ss2};
        pg8::gemm_phase<EpiOut, pg8::StaticOrder, true, true>(ring, gm, S, E);
    }
    SEAM(5);
    if (IN(6)) {
        pg8::Gemm gm{Y, (const bf16*)(ws + OFF_WUP), M, FF, D}; pg8::StaticOrder S; S.init(M, FF, gridDim.x, (int)blockIdx.x);
        EpiUp E{ss2, UPB};
        for (int rep = 0; rep < REPS(6); ++rep)
        pg8::gemm_phase<EpiUp, pg8::StaticOrder, true, true>(ring, gm, S, E);
    }
    SEAM(6);
    if (IN(7)) {
        pg8::Gemm gm{UPB, (const bf16*)(ws + OFF_WDN), M, D, FF}; pg8::StaticOrder S; S.init(M, D, gridDim.x, (int)blockIdx.x);
        EpiDown E{P.out};
        pg8::gemm_phase<EpiDown, pg8::StaticOrder, true, true>(ring, gm, S, E);
    }
#undef IN
#undef SEAM
}

#ifndef MK_N_LAUNCHES
#define MK_N_LAUNCHES 1
#endif
extern "C" void kernel_launch(void* const* d_in, const int* in_sizes, int n_in, void* d_out, int out_size, void* d_ws, size_t ws_size, hipStream_t stream) {
    static int grid = 0;
    if (grid == 0) {
        if (n_in != 22 || out_size != M * D || ws_size < WS_NEED) { fprintf(stderr, "kernel_launch: unexpected shapes (n_in %d out %d ws %zu)\n", n_in, out_size, ws_size); grid = -1; return; }
        int dev = 0, cus = 0, per_cu = 0;
        hipGetDevice(&dev); hipDeviceGetAttribute(&cus, hipDeviceAttributeMultiprocessorCount, dev);
        if (hipFuncSetAttribute((const void*)fwd_megakernel, hipFuncAttributeMaxDynamicSharedMemorySize, LDS_BYTES) != hipSuccess) { fprintf(stderr, "kernel_launch: hipFuncSetAttribute failed\n"); grid = -1; return; }
        if (hipOccupancyMaxActiveBlocksPerMultiprocessor(&per_cu, (const void*)fwd_megakernel, 512, LDS_BYTES) != hipSuccess || per_cu < 1) { fprintf(stderr, "kernel_launch: occupancy query says %d\n", per_cu); per_cu = 1; }
        (void)hipGetLastError();
        grid = cus;
    }
    if (grid < 0) return;
    Params p{};
    const float** f = &p.xp;
    for (int i = 0; i < 22; ++i) f[i] = (const float*)d_in[i];
    p.out = (float*)d_out; p.ws = (unsigned char*)d_ws;
    if (hipMemsetAsync((char*)d_ws + OFF_BAR, 0, 16384, stream) != hipSuccess) { fprintf(stderr, "kernel_launch: hipMemsetAsync failed\n"); return; }
    if (MK_N_LAUNCHES == 1) {
        p.ph_lo = 0; p.ph_hi = 8;
        void* args[] = {&p};
        hipError_t e = hipLaunchCooperativeKernel((const void*)fwd_megakernel, dim3(grid), dim3(512), args, LDS_BYTES, stream);
        if (e != hipSuccess) fprintf(stderr, "cooperative launch failed: %s (grid %d)\n", hipGetErrorString(e), grid);
    } else {
        for (int ph = 0; ph < 8; ++ph) { p.ph_lo = ph; p.ph_hi = ph + 1;
            void* args[] = {&p};
            hipError_t e = hipLaunchCooperativeKernel((const void*)fwd_megakernel, dim3(grid), dim3(512), args, LDS_BYTES, stream);
            if (e != hipSuccess) { fprintf(stderr, "launch %d failed: %s\n", ph, hipGetErrorString(e)); break; } }
    }
}
```

```cpp
#include <hip/hip_runtime.h>
#include <hip/hip_cooperative_groups.h>
#include <cstdio>
#include <cstdint>
namespace cg = cooperative_groups;
namespace pg8 {
#define PG8_LAS __attribute__((address_space(3)))
typedef unsigned short bf16_t;
typedef short bf16x8 __attribute__((ext_vector_type(8)));
typedef float f32x4 __attribute__((ext_vector_type(4)));
typedef unsigned u32x4 __attribute__((ext_vector_type(4)));
constexpr int BM = 256, BK = 64, HALF = 128, HTB = HALF * BK * 2  , STAGE_BYTES = 8 * HTB, NXCD = 8, WGM = 8;

__host__ __device__ __forceinline__ int lds_byte(int r, int c) { const int st = (r >> 4) * 2 + (c >> 5), rr = r & 15, cc = c & 31, ob = rr * 64 + cc * 2; return st * 1024 + (ob ^ (((ob >> 9) & 1) << 5)); }
__host__ __device__ __forceinline__ void stage_rc(int b, int& R, int& C) { const int st = b / 1024, sb = b % 1024, swz = sb ^ (((sb >> 9) & 1) << 5); R = (st >> 1) * 16 + swz / 64; C = (st & 1) * 32 + (swz % 64) / 2; }
__host__ __device__ __forceinline__ int perm32(int rho) { const int n = rho >> 4, i = rho & 15; return 8 * (i >> 2) + 4 * n + (i & 3); }

struct Unit { int pm, pn; };
struct Gemm { const bf16_t* A; const bf16_t* Bt; int M, N, K; };

struct StaticOrder {
    int nM, nN, nwg, G, c;
    __host__ __device__ void init(int M, int N, int G_, int c_) { nM = M / BM; nN = N / BM; nwg = nM * nN; G = G_; c = c_; }
    __host__ __device__ bool next(int i, Unit& u) const {
        const long L = (long)i * G + c; if (L >= nwg) return false;
        int wgid = (int)L; { const int q = nwg / NXCD, r = nwg % NXCD, xcd = wgid % NXCD, off = wgid / NXCD; wgid = (xcd < r ? xcd * (q + 1) : r * (q + 1) + (xcd - r) * q) + off; }
        const int nig = WGM * nN, gid = wgid / nig, fm = gid * WGM, gsz = (nM - fm) < WGM ? (nM - fm) : WGM;
        u.pm = fm + ((wgid % nig) % gsz); u.pn = (wgid % nig) / gsz; return true;
    }
    __device__ __forceinline__ void a_ready(const Unit&) const {}
    __device__ __forceinline__ void done(const Unit&) const {}
};
__device__ __forceinline__ unsigned cvt_pk_bf16(float lo, float hi) { unsigned r; asm volatile("v_cvt_pk_bf16_f32 %0, %1, %2" : "=v"(r) : "v"(lo), "v"(hi)); return r; }
typedef float f32x2 __attribute__((ext_vector_type(2)));
template <class Epi, class Sched, bool ALIGN_EPI = false, bool SP2 = false>
__device__ __forceinline__ void gemm_phase(PG8_LAS unsigned char* lds, const Gemm g, const Sched& S, const Epi& E) {
    const int tid = threadIdx.x, wid = __builtin_amdgcn_readfirstlane(tid >> 6), lane = tid & 63, wr = wid >> 2, wc = wid & 3, fr = lane & 15, fq = lane >> 4;
    const int K = g.K, nt = K / BK;
    unsigned voffA[2], voffB[2];
#pragma unroll
    for (int i = 0; i < 2; ++i) { int R, C; stage_rc(tid * 16 + i * 8192, R, C); const int Rb = Epi::PERM ? ((R & ~31) + perm32(R & 31)) : R;
        voffA[i] = (unsigned)(R * K + C) * 2u; voffB[i] = (unsigned)(Rb * K + C) * 2u; }
    const size_t kstep = (size_t)(BK * 2);
    const size_t hstep = (size_t)HALF * K * 2;
    const size_t tstep = 2 * hstep;
    const unsigned ldsw = (unsigned)wid * 1024u;
    const int aoff = lds_byte(wr * 64 + fr, fq * 8), boff = lds_byte(wc * 32 + fr, fq * 8);
#define PG8_SA(b, h) (((b) * 2 + (h)) * HTB)
#define PG8_SB(b, h) ((4 + (b) * 2 + (h)) * HTB)
#define PG8_STAGE(bufoff, gbase, voff) do { _Pragma("unroll") for (int _i = 0; _i < 2; ++_i) \
        __builtin_amdgcn_global_load_lds((const unsigned*)((const char*)(gbase) + (voff)[_i]), (PG8_LAS unsigned*)(lds + (bufoff) + ldsw + _i * 8192), 16, 0, 0); } while (0)
#define PG8_LDA(dst, b, h) do { _Pragma("unroll") for (int m = 0; m < 4; ++m) _Pragma("unroll") for (int k = 0; k < 2; ++k) dst[m][k] = *(const PG8_LAS bf16x8*)(lds + PG8_SA(b, h) + aoff + m * 2048 + k * 1024); } while (0)
#define PG8_LDB(dst, b, h) do { _Pragma("unroll") for (int n = 0; n < 2; ++n) _Pragma("unroll") for (int k = 0; k < 2; ++k) dst[n][k] = *(const PG8_LAS bf16x8*)(lds + PG8_SB(b, h) + boff + n * 2048 + k * 1024); } while (0)
#define PG8_MMA(ai, bj, At, Bt) do { __builtin_amdgcn_s_setprio(1); _Pragma("unroll") for (int m = 0; m < 4; ++m) _Pragma("unroll") for (int n = 0; n < 2; ++n) _Pragma("unroll") for (int k = 0; k < 2; ++k) \
        acc[ai][bj][m][n] = __builtin_amdgcn_mfma_f32_16x16x32_bf16(Bt[n][k], At[m][k], acc[ai][bj][m][n], 0, 0, 0); __builtin_amdgcn_s_setprio(0); } while (0)
#define PG8_WAIT_V(n) asm volatile("s_waitcnt vmcnt(" #n ")" ::: "memory")
#define PG8_WAIT_L(n) asm volatile("s_waitcnt lgkmcnt(" #n ")" ::: "memory")
#define PG8_BAR __builtin_amdgcn_s_barrier()
#define PG8_SCHED __builtin_amdgcn_sched_barrier(0)
    Unit cur, nxt; int ui = 0;
    if (!S.next(0, cur)) return;
    f32x4 acc[2][2][4][2];
#pragma unroll
    for (int a = 0; a < 2; ++a)
#pragma unroll
        for (int b = 0; b < 2; ++b)
#pragma unroll
            for (int m = 0; m < 4; ++m)
#pragma unroll
                for (int n = 0; n < 2; ++n) acc[a][b][m][n] = (f32x4){0.f, 0.f, 0.f, 0.f};
    bf16x8 At[4][2], B0[2][2], B1[2][2];
    const char* cA = (const char*)g.A + (size_t)cur.pm * tstep; const char* cB = (const char*)g.Bt + (size_t)cur.pn * tstep;
    S.a_ready(cur);
    if constexpr (SP2) {
        PG8_STAGE(PG8_SB(0, 0), cB, voffB); PG8_STAGE(PG8_SB(0, 1), cB + hstep, voffB); PG8_STAGE(PG8_SA(0, 0), cA, voffA); PG8_STAGE(PG8_SA(0, 1), cA + hstep, voffA);
        if (wr == 1) PG8_BAR;
        PG8_WAIT_V(2); PG8_BAR;
        PG8_STAGE(PG8_SB(1, 0), cB + kstep, voffB); PG8_STAGE(PG8_SA(1, 0), cA + kstep, voffA); PG8_STAGE(PG8_SB(1, 1), cB + hstep + kstep, voffB);
        PG8_WAIT_V(6); PG8_BAR;
    } else {
        PG8_STAGE(PG8_SB(0, 0), cB, voffB); PG8_STAGE(PG8_SA(0, 0), cA, voffA); PG8_STAGE(PG8_SB(0, 1), cB + hstep, voffB); PG8_STAGE(PG8_SA(0, 1), cA + hstep, voffA);
        if (wr == 1) PG8_BAR;
        PG8_WAIT_V(4); PG8_BAR;
        PG8_STAGE(PG8_SB(1, 0), cB + kstep, voffB); PG8_STAGE(PG8_SA(1, 0), cA + kstep, voffA); PG8_STAGE(PG8_SB(1, 1), cB + hstep + kstep, voffB);
        PG8_WAIT_V(6); PG8_BAR;
    }
    for (;;) {
        const bool has_next = S.next(ui + 1, nxt);
        const char* nA = has_next ? (const char*)g.A + (size_t)nxt.pm * tstep : cA; const char* nB = has_next ? (const char*)g.Bt + (size_t)nxt.pn * tstep : cB;
        for (int t = 0; t < nt; t += 2) {
            const bool last = (t == nt - 2);
            const char* a1 = cA + (size_t)(t + 1) * kstep;
            const char* a2 = last ? nA : cA + (size_t)(t + 2) * kstep; const char* b2 = last ? nB : cB + (size_t)(t + 2) * kstep;
            const char* a3 = a2 + kstep; const char* b3 = b2 + kstep;
            if (last && has_next) S.a_ready(nxt);
            if constexpr (SP2) {
            PG8_LDB(B0, 0, 0); PG8_LDB(B1, 0, 1); PG8_SCHED; PG8_LDA(At, 0, 0); PG8_STAGE(PG8_SA(1, 1), a1 + hstep, voffA);
            PG8_WAIT_V(8); PG8_WAIT_L(0); PG8_BAR; PG8_MMA(0, 0, At, B0); PG8_MMA(0, 1, At, B1); PG8_BAR; PG8_SCHED;
            PG8_LDA(At, 0, 1); PG8_STAGE(PG8_SB(0, 0), b2, voffB); PG8_STAGE(PG8_SB(0, 1), b2 + hstep, voffB); PG8_STAGE(PG8_SA(0, 0), a2, voffA);
            PG8_WAIT_V(8); PG8_WAIT_L(0); PG8_BAR; PG8_MMA(1, 0, At, B0); PG8_MMA(1, 1, At, B1); PG8_BAR; PG8_SCHED;
            PG8_LDB(B0, 1, 0); PG8_LDB(B1, 1, 1); PG8_SCHED; PG8_LDA(At, 1, 0); PG8_STAGE(PG8_SA(0, 1), a2 + hstep, voffA);
            PG8_WAIT_V(8); PG8_WAIT_L(0); PG8_BAR; PG8_MMA(0, 0, At, B0); PG8_MMA(0, 1, At, B1); PG8_BAR; PG8_SCHED;
            PG8_LDA(At, 1, 1); PG8_STAGE(PG8_SB(1, 0), b3, voffB); PG8_STAGE(PG8_SB(1, 1), b3 + hstep, voffB); PG8_STAGE(PG8_SA(1, 0), a3, voffA);
            PG8_WAIT_V(8); PG8_WAIT_L(0); PG8_BAR; PG8_MMA(1, 0, At, B0); PG8_MMA(1, 1, At, B1); PG8_BAR; PG8_SCHED;
            } else {
            PG8_LDB(B0, 0, 0); PG8_SCHED; PG8_LDA(At, 0, 0); PG8_STAGE(PG8_SA(1, 1), a1 + hstep, voffA);
            PG8_WAIT_L(8); PG8_BAR; PG8_WAIT_L(0); PG8_MMA(0, 0, At, B0); PG8_BAR; PG8_SCHED;
            PG8_LDB(B1, 0, 1); PG8_STAGE(PG8_SB(0, 0), b2, voffB);
            PG8_BAR; PG8_WAIT_L(0); PG8_MMA(0, 1, At, B1); PG8_BAR;
            PG8_LDA(At, 0, 1); PG8_STAGE(PG8_SA(0, 0), a2, voffA);
            PG8_BAR; PG8_WAIT_L(0); PG8_MMA(1, 0, At, B0); PG8_BAR; PG8_SCHED;
            PG8_STAGE(PG8_SB(0, 1), b2 + hstep, voffB);
            PG8_WAIT_V(6); PG8_BAR; PG8_MMA(1, 1, At, B1); PG8_BAR;
            PG8_LDB(B0, 1, 0); PG8_SCHED; PG8_LDA(At, 1, 0); PG8_STAGE(PG8_SA(0, 1), a2 + hstep, voffA);
            PG8_WAIT_L(8); PG8_BAR; PG8_WAIT_L(0); PG8_MMA(0, 0, At, B0); PG8_BAR; PG8_SCHED;
            PG8_LDB(B1, 1, 1); PG8_STAGE(PG8_SB(1, 0), b3, voffB);
            PG8_BAR; PG8_WAIT_L(0); PG8_MMA(0, 1, At, B1); PG8_BAR;
            PG8_LDA(At, 1, 1); PG8_STAGE(PG8_SA(1, 0), a3, voffA);
            PG8_BAR; PG8_WAIT_L(0); PG8_MMA(1, 0, At, B0); PG8_BAR; PG8_SCHED;
            PG8_STAGE(PG8_SB(1, 1), b3 + hstep, voffB);
            PG8_WAIT_V(6); PG8_BAR; PG8_MMA(1, 1, At, B1); PG8_BAR;
            }
        }
        if constexpr (ALIGN_EPI) { if (wr == 0) PG8_BAR; }
        if constexpr (!Epi::AFTER_DRAIN) { E(acc, cur, wr, wc, fr, fq); S.done(cur); }
        if (!has_next) break;
#pragma unroll
        for (int a = 0; a < 2; ++a)
#pragma unroll
            for (int b = 0; b < 2; ++b)
#pragma unroll
                for (int m = 0; m < 4; ++m)
#pragma unroll
                    for (int n = 0; n < 2; ++n) acc[a][b][m][n] = (f32x4){0.f, 0.f, 0.f, 0.f};
        cur = nxt; cA = nA; cB = nB; ++ui;
        if constexpr (ALIGN_EPI) { if (wr == 1) PG8_BAR; }
    }
    PG8_WAIT_V(0);
    if constexpr (!ALIGN_EPI) { if (wr == 0) PG8_BAR; }
    PG8_BAR;
    if constexpr (Epi::AFTER_DRAIN) { E.fused(acc, cur, wr, wc, fr, fq, lds, wid, lane); S.done(cur); }
#undef PG8_SA
#undef PG8_SB
#undef PG8_STAGE
#undef PG8_LDA
#undef PG8_LDB
#undef PG8_MMA
#undef PG8_WAIT_V
#undef PG8_WAIT_L
#undef PG8_BAR
#undef PG8_SCHED
}
}

constexpr int D = 1024, NSEQ = 24, L = 4096, M = NSEQ * L, NIN = 4608, FF = 4096, MP = 8 * 4096;
constexpr int LDQ = 1536;
constexpr int LDG = 2048;
constexpr float EPS = 1e-6f, LOG2E = 1.4426950408889634f;
constexpr size_t MiB = 1u << 20;
constexpr size_t OFF_SS2 = 0, OFF_M0 = 393216, OFF_AP = 524288, OFF_AT = 589824, OFF_AT16 = 655360, OFF_BB = 720896, OFF_CF = 1245184;
constexpr size_t OFF_WIN = 2 * MiB, OFF_WGLU = 11 * MiB, OFF_WOUT = 13 * MiB, OFF_WUP = 15 * MiB, OFF_WDN = 23 * MiB;
constexpr size_t OFF_Y = 40 * MiB, OFF_XB = 232 * MiB, OFF_QKVU = 424 * MiB, OFF_UG = 712 * MiB, OFF_BBA = 31 * MiB, OFF_CAF = 31 * MiB + 524288, OFF_K0 = 32 * MiB, OFF_UP = 232 * MiB, WS_NEED = 1000 * MiB;
constexpr int LDS_BYTES = 147456;
#ifndef REPMASK
#define REPMASK 0
#endif
#define REPS(k) (((REPMASK >> (k)) & 1) ? 2 : 1)

typedef unsigned short bf16;
typedef short bf16x8 __attribute__((ext_vector_type(8)));
typedef short s16x4 __attribute__((ext_vector_type(4)));
typedef float f32x4 __attribute__((ext_vector_type(4)));
typedef float f32x2 __attribute__((ext_vector_type(2)));
typedef unsigned u32x4 __attribute__((ext_vector_type(4)));
typedef unsigned u32x2 __attribute__((ext_vector_type(2)));

__device__ __forceinline__ unsigned f2bf(float f) { unsigned u = __builtin_bit_cast(unsigned, f); return (u + 0x7fffu + ((u >> 16) & 1u)) >> 16; }
typedef __bf16 bf16x2_t __attribute__((ext_vector_type(2)));
__device__ __forceinline__ unsigned pk2(float lo, float hi) { const f32x2 v = {lo, hi}; const bf16x2_t b = __builtin_convertvector(v, bf16x2_t); return __builtin_bit_cast(unsigned, b); }
__device__ __forceinline__ unsigned pk2v(f32x2 v) { const bf16x2_t b = __builtin_convertvector(v, bf16x2_t); return __builtin_bit_cast(unsigned, b); }
__device__ __forceinline__ float bflo(unsigned w) { return __builtin_bit_cast(float, w << 16); }
__device__ __forceinline__ float bfhi(unsigned w) { return __builtin_bit_cast(float, w & 0xffff0000u); }
__device__ __forceinline__ float fsigmoid(float x) { return __builtin_amdgcn_rcpf(1.0f + __builtin_amdgcn_exp2f(-LOG2E * x)); }
__device__ __forceinline__ float wave_sum(float v) {
#pragma unroll
    for (int o = 1; o < 64; o <<= 1) v += __shfl_xor(v, o);
    return v;
}

struct Params {
    const float *xp, *xs, *rel_table, *ln1, *w_in, *q_gain, *k_gain, *sink, *lam_re, *lam_im, *log_dt, *b_re, *b_im, *c_re, *c_im, *d_skip, *w_glu, *b_glu, *w_out, *ln2, *w_up, *w_down;
    float* out; unsigned char* ws; int ph_lo, ph_hi;
};

using pg8::Unit; using pg8::HALF; using pg8::BM;
struct EpiProj {
    static constexpr bool PERM = true, AFTER_DRAIN = false;
    bf16* QKV; bf16* UG; bf16* GATES;
    __device__ __forceinline__ void operator()(const f32x4 (&acc)[2][2][4][2], const Unit& u, int wr, int wc, int fr, int fq) const {
        const int row0 = u.pm * BM + wr * 64 + fr, col0 = wc * 32 + 8 * fq;
        if (u.pn >= 6 && u.pn < 10) {
            const int c0 = (u.pn - 6) * 256 + col0;
#pragma unroll
            for (int ai = 0; ai < 2; ++ai)
#pragma unroll
                for (int m = 0; m < 4; ++m) { const size_t row = (size_t)(row0 + ai * HALF + m * 16);
#pragma unroll
                    for (int bj = 0; bj < 2; ++bj) { const int c = c0 + bj * HALF; const f32x4 v0 = acc[ai][bj][m][0], v1 = acc[ai][bj][m][1];
                        u32x4 w; w.x = pk2(v0[0], v0[1]); w.y = pk2(v0[2], v0[3]); w.z = pk2(v1[0], v1[1]); w.w = pk2(v1[2], v1[3]);
                        *(u32x4*)(UG + ((size_t)(c >> 4) * M + row) * 16 + (c & 15)) = w; } }
            return;
        }
        const bool gate = u.pn >= 10;
        bf16* base = gate ? GATES + (u.pn - 10) * 256 : QKV + u.pn * 256;
        const int ldc = gate ? LDG : LDQ;
#pragma unroll
        for (int ai = 0; ai < 2; ++ai)
#pragma unroll
            for (int m = 0; m < 4; ++m) { bf16* rowp = base + (size_t)(row0 + ai * HALF + m * 16) * ldc + col0;
#pragma unroll
                for (int bj = 0; bj < 2; ++bj) { f32x4 v0 = acc[ai][bj][m][0], v1 = acc[ai][bj][m][1];
                    if (gate) {
#pragma unroll
                        for (int e = 0; e < 4; ++e) { v0[e] = fsigmoid(v0[e]); v1[e] = fsigmoid(v1[e]); } }
                    u32x4 w; w.x = pk2(v0[0], v0[1]); w.y = pk2(v0[2], v0[3]); w.z = pk2(v1[0], v1[1]); w.w = pk2(v1[2], v1[3]);
                    *(u32x4*)(rowp + bj * HALF) = w; } }
    }
};
struct EpiGlu {
    static constexpr bool PERM = true, AFTER_DRAIN = false;
    const bf16* Y; const bf16* ATTG; const bf16* GS; const float* bglu; bf16* MIXED;
    __device__ __forceinline__ void operator()(const f32x4 (&acc)[2][2][4][2], const Unit& u, int wr, int wc, int fr, int fq) const {
        const int row0 = u.pm * BM + wr * 64 + fr, col0 = u.pn * BM + wc * 32 + 8 * fq;
#pragma unroll
        for (int bj = 0; bj < 2; ++bj) {
            const int col = col0 + bj * HALF;
            const f32x4 b0 = *(const f32x4*)(bglu + col), b1 = *(const f32x4*)(bglu + col + 4);
#pragma unroll
            for (int ai = 0; ai < 2; ++ai) {
                u32x4 yv[4], av[4], gv[4];
#pragma unroll
                for (int m = 0; m < 4; ++m) { const size_t row = (size_t)(row0 + ai * HALF + m * 16);
                    yv[m] = *(const u32x4*)(Y + row * D + col); av[m] = *(const u32x4*)(ATTG + row * LDQ + col); gv[m] = *(const u32x4*)(GS + row * LDG + col); }
#pragma unroll
                for (int m = 0; m < 4; ++m) { const size_t row = (size_t)(row0 + ai * HALF + m * 16);
                    const f32x4 z0 = acc[ai][bj][m][0] + b0, z1 = acc[ai][bj][m][1] + b1;
                    float r[8];
#pragma unroll
                    for (int e = 0; e < 4; ++e) { const float z = e < 2 ? z0[2 * e] : z1[2 * (e - 2)], zz = e < 2 ? z0[2 * e + 1] : z1[2 * (e - 2) + 1];
                        r[2 * e] = bflo(av[m][e]) + bflo(gv[m][e]) * bflo(yv[m][e]) * fsigmoid(z);
                        r[2 * e + 1] = bfhi(av[m][e]) + bfhi(gv[m][e]) * bfhi(yv[m][e]) * fsigmoid(zz); }
                    u32x4 w; w.x = pk2(r[0], r[1]); w.y = pk2(r[2], r[3]); w.z = pk2(r[4], r[5]); w.w = pk2(r[6], r[7]);
                    *(u32x4*)(MIXED + row * D + col) = w; } } }
    }
};
struct EpiOut {
    static constexpr bool PERM = true, AFTER_DRAIN = false;
    const float* xp; const float* xs; float* out; bf16* X1B; float* ss2;
    __device__ __forceinline__ void operator()(const f32x4 (&acc)[2][2][4][2], const Unit& u, int wr, int wc, int fr, int fq) const {
        const int row0 = u.pm * BM + wr * 64 + fr, col0 = u.pn * BM + wc * 32 + 8 * fq;
        const float* xb = (u.pm * BM < MP) ? xp : xs - (size_t)MP * D;
#pragma unroll
        for (int ai = 0; ai < 2; ++ai)
#pragma unroll
            for (int mh = 0; mh < 2; ++mh) {
                f32x4 xv[2][2][2];
#pragma unroll
                for (int mm = 0; mm < 2; ++mm)
#pragma unroll
                    for (int bj = 0; bj < 2; ++bj) { const size_t off = (size_t)(row0 + ai * HALF + (2 * mh + mm) * 16) * D + col0 + bj * HALF;
                        xv[mm][bj][0] = *(const f32x4*)(xb + off); xv[mm][bj][1] = *(const f32x4*)(xb + off + 4); }
#pragma unroll
                for (int mm = 0; mm < 2; ++mm) { const int m = 2 * mh + mm; const size_t row = (size_t)(row0 + ai * HALF + m * 16); float ssq = 0.f;
#pragma unroll
                    for (int bj = 0; bj < 2; ++bj) { const size_t off = row * D + col0 + bj * HALF;
                        const f32x4 v0 = acc[ai][bj][m][0] + xv[mm][bj][0], v1 = acc[ai][bj][m][1] + xv[mm][bj][1];
                        *(f32x4*)(out + off) = v0; *(f32x4*)(out + off + 4) = v1;
                        ssq += (v0[0] * v0[0] + v0[1] * v0[1]) + (v0[2] * v0[2] + v0[3] * v0[3]) + (v1[0] * v1[0] + v1[1] * v1[1]) + (v1[2] * v1[2] + v1[3] * v1[3]);
                        u32x4 w; w.x = pk2(v0[0], v0[1]); w.y = pk2(v0[2], v0[3]); w.z = pk2(v1[0], v1[1]); w.w = pk2(v1[2], v1[3]);
                        *(u32x4*)(X1B + off) = w; }
                    ssq += __shfl_xor(ssq, 16); ssq += __shfl_xor(ssq, 32);
                    if (fq == 0) atomicAdd(ss2 + row, ssq); } }
    }
};
struct EpiUp {
    static constexpr bool PERM = true, AFTER_DRAIN = false;
    const float* ss2; bf16* UP;
    __device__ __forceinline__ void operator()(const f32x4 (&acc)[2][2][4][2], const Unit& u, int wr, int wc, int fr, int fq) const {
        const int row0 = u.pm * BM + wr * 64 + fr, col0 = u.pn * BM + wc * 32 + 8 * fq;
#pragma unroll
        for (int ai = 0; ai < 2; ++ai)
#pragma unroll
            for (int m = 0; m < 4; ++m) { const size_t row = (size_t)(row0 + ai * HALF + m * 16);
                const float r2 = __builtin_amdgcn_rsqf(ss2[row] * (1.0f / D) + EPS);
#pragma unroll
                for (int bj = 0; bj < 2; ++bj) { f32x4 v0 = acc[ai][bj][m][0] * r2, v1 = acc[ai][bj][m][1] * r2;
#pragma unroll
                    for (int e = 0; e < 4; ++e) { const float a = fmaxf(v0[e], 0.f), b = fmaxf(v1[e], 0.f); v0[e] = a * a; v1[e] = b * b; }
                    u32x4 w; w.x = pk2(v0[0], v0[1]); w.y = pk2(v0[2], v0[3]); w.z = pk2(v1[0], v1[1]); w.w = pk2(v1[2], v1[3]);
                    *(u32x4*)(UP + row * FF + col0 + bj * HALF) = w; } }
    }
};
struct EpiDown {
    static constexpr bool PERM = true, AFTER_DRAIN = false;
    float* out;
    __device__ __forceinline__ void operator()(const f32x4 (&acc)[2][2][4][2], const Unit& u, int wr, int wc, int fr, int fq) const {
        const int row0 = u.pm * BM + wr * 64 + fr, col0 = u.pn * BM + wc * 32 + 8 * fq;
#pragma unroll
        for (int ai = 0; ai < 2; ++ai)
#pragma unroll
            for (int mh = 0; mh < 2; ++mh) {
                f32x4 xv[2][2][2];
#pragma unroll
                for (int mm = 0; mm < 2; ++mm)
#pragma unroll
                    for (int bj = 0; bj < 2; ++bj) { const float* p = out + (size_t)(row0 + ai * HALF + (2 * mh + mm) * 16) * D + col0 + bj * HALF; xv[mm][bj][0] = *(const f32x4*)p; xv[mm][bj][1] = *(const f32x4*)(p + 4); }
#pragma unroll
                for (int mm = 0; mm < 2; ++mm)
#pragma unroll
                    for (int bj = 0; bj < 2; ++bj) { const int m = 2 * mh + mm; float* p = out + (size_t)(row0 + ai * HALF + m * 16) * D + col0 + bj * HALF;
                        *(f32x4*)p = acc[ai][bj][m][0] + xv[mm][bj][0]; *(f32x4*)(p + 4) = acc[ai][bj][m][1] + xv[mm][bj][1]; } }
    }
};

__device__ __forceinline__ void transpose_item(const float* W, int K, int N, bf16* WT, const float* kscale, float* scr, int item, int lane) {
    const int nblk = N / 32, kb = item / nblk, nb = item % nblk, k0 = 64 * kb, n0 = 32 * nb;
    float tv[32];
#pragma unroll
    for (int i = 0; i < 32; ++i) tv[i] = W[(size_t)(k0 + 2 * i + (lane >> 5)) * N + n0 + (lane & 31)];
#pragma unroll
    for (int i = 0; i < 32; ++i) { const int kk = 2 * i + (lane >> 5); float v = tv[i]; if (kscale) v *= kscale[k0 + kk]; scr[kk * 33 + (lane & 31)] = v; }
    asm volatile("s_waitcnt lgkmcnt(0)" ::: "memory");
    const int c = lane & 7;
#pragma unroll
    for (int j = 0; j < 4; ++j) { const int n = (lane >> 3) + 8 * j; const float* s = scr + (8 * c) * 33 + n;
        u32x4 o; o.x = pk2(s[0 * 33], s[1 * 33]); o.y = pk2(s[2 * 33], s[3 * 33]); o.z = pk2(s[4 * 33], s[5 * 33]); o.w = pk2(s[6 * 33], s[7 * 33]);
        *(u32x4*)(WT + (size_t)(n0 + n) * K + k0 + 8 * c) = o; }
    asm volatile("s_waitcnt lgkmcnt(0)" ::: "memory");
}
__device__ __forceinline__ void sincos_d(double x, double& s, double& c) {
    const double k = __builtin_rint(x * 0.63661977236758134308), r = (x - k * 1.5707963267948966) - k * 6.123233995736766e-17, r2 = r * r;
    double sp = 1.0, cp = 1.0;
#pragma unroll
    for (int i = 10; i >= 1; --i) { sp = 1.0 - sp * r2 / (double)((2 * i) * (2 * i + 1)); cp = 1.0 - cp * r2 / (double)((2 * i - 1) * (2 * i)); }
    sp *= r;
    const int q = ((int)k) & 3;
    s = (q == 0) ? sp : (q == 1) ? cp : (q == 2) ? -sp : -cp;
    c = (q == 0) ? cp : (q == 1) ? -sp : (q == 2) ? -cp : sp;
}
__device__ __forceinline__ void ssm_disc(const Params& P, int dg, int p, double& are, double& aim, double& cre, double& cim) {
    const double dt = exp((double)P.log_dt[dg]);
    const double lr = (double)P.lam_re[dg * 64 + p], li = (double)P.lam_im[dg * 64 + p];
    const double mag = exp(lr * dt); double sn, cs; sincos_d(li * dt, sn, cs);
    are = mag * cs; aim = mag * sn;
    const double den = lr * lr + li * li, nr = are - 1.0, ni = aim;
    cre = (nr * lr + ni * li) / den; cim = (ni * lr - nr * li) / den;
}
__device__ __forceinline__ void ssm_prep(const Params& P, int dg, int lane, float* scr) {
    unsigned char* ws = P.ws;
    const int p = lane;
    double are, aim, cre, cim; ssm_disc(P, dg, p, are, aim, cre, cim);
    ((f32x2*)(ws + OFF_AP))[dg * 64 + p] = (f32x2){(float)are, (float)aim};
    double pr = are, pi = aim;
#pragma unroll 1
    for (int i = 0; i < 10; ++i) { const double nr_ = pr * pr - pi * pi, ni_ = 2.0 * pr * pi; pr = nr_; pi = ni_;
        if (i == 5) ((f32x2*)(ws + OFF_AT))[dg * 64 + p] = (f32x2){(float)pr, (float)pi}; }
    ((f32x2*)(ws + OFF_AT16))[dg * 64 + p] = (f32x2){(float)pr, (float)pi};
    bf16* BB = (bf16*)(ws + OFF_BB); bf16* BBA = (bf16*)(ws + OFF_BBA);
#pragma unroll 4
    for (int c = 0; c < 16; ++c) { const double br = (double)P.b_re[(size_t)(dg * 64 + p) * 16 + c], bi = (double)P.b_im[(size_t)(dg * 64 + p) * 16 + c];
        const double bbr = cre * br - cim * bi, bbi = cre * bi + cim * br;
        BB[((size_t)(dg * 2 + 0) * 64 + p) * 16 + c] = (bf16)f2bf((float)bbr);
        BB[((size_t)(dg * 2 + 1) * 64 + p) * 16 + c] = (bf16)f2bf((float)bbi);
        BBA[((size_t)(dg * 2 + 0) * 64 + p) * 16 + c] = (bf16)f2bf((float)(are * bbr - aim * bbi));
        BBA[((size_t)(dg * 2 + 1) * 64 + p) * 16 + c] = (bf16)f2bf((float)(are * bbi + aim * bbr));
        scr[(p * 16 + c) * 2] = (float)bbr; scr[(p * 16 + c) * 2 + 1] = (float)bbi; }
    scr[2048 + 2 * p] = (float)are; scr[2048 + 2 * p + 1] = (float)aim;
    asm volatile("s_waitcnt lgkmcnt(0)" ::: "memory");
    bf16* CF = (bf16*)(ws + OFF_CF); bf16* CAF = (bf16*)(ws + OFF_CAF);
    for (int e = lane; e < 2048; e += 64) { const int jj = e & 7, fq = (e >> 3) & 3, c = (e >> 5) & 15, s = e >> 9;
        const int pp = 16 * (2 * (s & 1) + (jj >> 2)) + 4 * fq + (jj & 3);
        const float v = (s < 2) ? P.c_re[(size_t)(dg * 16 + c) * 64 + pp] : -P.c_im[(size_t)(dg * 16 + c) * 64 + pp];
        CF[(size_t)dg * 2048 + e] = (bf16)f2bf(v);
        const float cr = P.c_re[(size_t)(dg * 16 + c) * 64 + pp], ci = P.c_im[(size_t)(dg * 16 + c) * 64 + pp], ar_ = scr[2048 + 2 * pp], ai_ = scr[2048 + 2 * pp + 1];
        CAF[(size_t)dg * 2048 + e] = (bf16)f2bf((s < 2) ? cr * ar_ - ci * ai_ : -(cr * ai_ + ci * ar_)); }
    bf16* K0 = (bf16*)(ws + OFF_K0);
    { const int co = lane >> 2, cin0 = (lane & 3) * 4; float acc[4] = {0.f, 0.f, 0.f, 0.f};
#pragma unroll 8
        for (int pp = 0; pp < 64; ++pp) { const float cr = P.c_re[(size_t)(dg * 16 + co) * 64 + pp], ci = P.c_im[(size_t)(dg * 16 + co) * 64 + pp];
#pragma unroll
            for (int i = 0; i < 4; ++i) acc[i] += cr * scr[(pp * 16 + cin0 + i) * 2] - ci * scr[(pp * 16 + cin0 + i) * 2 + 1]; }
        *(u32x2*)(K0 + (size_t)dg * 256 + lane * 4) = (u32x2){pk2(acc[0], acc[1]), pk2(acc[2], acc[3])}; }
    asm volatile("s_waitcnt lgkmcnt(0)" ::: "memory");
}
__device__ __forceinline__ void p0_prologue(const Params& P, unsigned char* lds, int tid, int wave, int lane) {
    unsigned char* ws = P.ws;
    float* scr = (float*)(lds + wave * 16384);
    const int gw = blockIdx.x * 8 + wave, NGW = gridDim.x * 8;
    constexpr int I_IN = 16 * (NIN / 32), I_G = 16 * 32, I_UP = 16 * (FF / 32), I_DN = (FF / 64) * 32;
    constexpr int NITEMS = I_IN + 2 * I_G + I_UP + I_DN;
    for (int it = gw; it < NITEMS; it += NGW) {
        int r = it;
        if (r < I_IN) { transpose_item(P.w_in, D, NIN, (bf16*)(ws + OFF_WIN), nullptr, scr, r, lane); continue; } r -= I_IN;
        if (r < I_G) { transpose_item(P.w_glu, D, D, (bf16*)(ws + OFF_WGLU), nullptr, scr, r, lane); continue; } r -= I_G;
        if (r < I_G) { transpose_item(P.w_out, D, D, (bf16*)(ws + OFF_WOUT), nullptr, scr, r, lane); continue; } r -= I_G;
        if (r < I_UP) { transpose_item(P.w_up, D, FF, (bf16*)(ws + OFF_WUP), P.ln2, scr, r, lane); continue; } r -= I_UP;
        transpose_item(P.w_down, FF, D, (bf16*)(ws + OFF_WDN), nullptr, scr, r, lane);
    }
    if (wave == 7) for (int dg = blockIdx.x; dg < 128; dg += gridDim.x) ssm_prep(P, dg, lane, scr);
    if (blockIdx.x == gridDim.x - 1 && wave == 6) {
        float gq = fabsf(P.q_gain[lane]), gk = fabsf(P.k_gain[lane]);
#pragma unroll
        for (int o = 1; o < 64; o <<= 1) { gq = fmaxf(gq, __shfl_xor(gq, o)); gk = fmaxf(gk, __shfl_xor(gk, o)); }
        if (lane < 16) { float bm = 0.f; for (int b = 0; b < 32; ++b) bm = fmaxf(bm, fabsf(P.rel_table[b * 16 + lane]));
            ((float*)(ws + OFF_M0))[lane] = fmaxf((8.0f * gq * gk * 1.0001f + bm) * LOG2E, P.sink[lane] * LOG2E); }
    }
    float* ss2 = (float*)(ws + OFF_SS2);
    for (int i = blockIdx.x * 512 + tid; i < M; i += gridDim.x * 512) ss2[i] = 0.f;
    f32x4 gl[4];
#pragma unroll
    for (int j = 0; j < 4; ++j) gl[j] = ((const f32x4*)P.ln1)[lane + 64 * j];
    bf16* XB = (bf16*)(ws + OFF_XB);
    f32x4 v[4], vn[4], vnn[4];
    auto xrp = [&](int m) { return (const f32x4*)((m < MP) ? P.xp + (size_t)m * D : P.xs + (size_t)(m - MP) * D) + lane; };
    if (gw < M) { const f32x4* xr = xrp(gw);
#pragma unroll
        for (int j = 0; j < 4; ++j) v[j] = xr[64 * j]; }
    if (gw + NGW < M) { const f32x4* xr = xrp(gw + NGW);
#pragma unroll
        for (int j = 0; j < 4; ++j) vn[j] = xr[64 * j]; }
    for (int m = gw; m < M; m += NGW) {
        const int mnn = m + 2 * NGW;
        if (mnn < M) { const f32x4* xr = xrp(mnn);
#pragma unroll
            for (int j = 0; j < 4; ++j) vnn[j] = xr[64 * j]; }
        float s = 0.f;
#pragma unroll
        for (int j = 0; j < 4; ++j) s += (v[j].x * v[j].x + v[j].y * v[j].y) + (v[j].z * v[j].z + v[j].w * v[j].w);
        const float rstd = 1.0f / sqrtf(wave_sum(s) * (1.f / D) + EPS);
        u32x2* o8 = (u32x2*)(XB + (size_t)m * D) + lane;
#pragma unroll
        for (int j = 0; j < 4; ++j) { const f32x4 t = v[j] * rstd * gl[j]; o8[64 * j] = (u32x2){pk2(t.x, t.y), pk2(t.z, t.w)}; }
#pragma unroll
        for (int j = 0; j < 4; ++j) { v[j] = vn[j]; vn[j] = vnn[j]; }
    }
}

constexpr int KST = 72;
constexpr int AT_K = 0, AT_V = 2 * 64 * KST * 2, AT_TB = 4 * 64 * KST * 2, AT_Q = AT_TB + 8192;
__device__ __forceinline__ void attn_phase(const Params& P, unsigned char* lds, int tid_in, int w, int lane_in) {
    bf16* QKVU = (bf16*)(P.ws + OFF_QKVU);
    const bf16* GATES = (const bf16*)P.out;
    const int g = w >> 1, qh = w & 1;
    float* tb = (float*)(lds + AT_TB);
    int tb_kh = -1;
    for (int item = blockIdx.x; item < NSEQ * 32 * 4; item += gridDim.x) {
        int lane = lane_in; asm volatile("" : "+v"(lane));
        const int tid = w * 64 + lane, fr = lane & 15, fq = lane >> 4;
        const int kh = item & 3, n = (item >> 2) & 31, seq = item >> 7, h = kh * 4 + g;
        const size_t m0 = (size_t)seq * L + n * 128;
        __syncthreads();
        if (kh != tb_kh) {
            tb_kh = kh;
            for (int e = tid; e < 4 * 512; e += 512) { const int gg = e >> 9, idx = e & 511, rel = idx - 255; float v = -1e30f;
                if (rel >= -128 && rel <= 128) { const int na = rel < 0 ? -rel : rel;
                    int b = na < 8 ? na : 8 + (na >= 12) + (na >= 16) + (na >= 23) + (na >= 32) + (na >= 46) + (na >= 64) + (na >= 91);
                    b += rel > 0 ? 16 : 0; v = P.rel_table[b * 16 + kh * 4 + gg] * LOG2E - ((const float*)(P.ws + OFF_M0))[kh * 4 + gg]; }
                tb[e] = v; }
        }
        const int c_lo = (n == 0) ? 2 : 0, c_hi = (n == 31) ? 4 : 6;
        u32x4 kreg, vreg;
        auto gload = [&](int c) {
            const size_t mk = m0 - 128 + 64 * c;
            kreg = *(const u32x4*)(QKVU + (mk + (tid >> 3)) * LDQ + 1024 + kh * 64 + 8 * (tid & 7));
            vreg = *(const u32x4*)(QKVU + (mk + lane) * LDQ + 1280 + kh * 64 + 8 * w);
        };
        bf16x8* Qs = (bf16x8*)(lds + AT_Q + w * 8192) + lane;
#pragma unroll
        for (int qg = 0; qg < 4; ++qg)
#pragma unroll
            for (int ks = 0; ks < 2; ++ks)
                __builtin_amdgcn_global_load_lds((const unsigned*)(QKVU + (m0 + 64 * qh + 16 * qg + fr) * LDQ + h * 64 + 32 * ks + 8 * fq),
                                                 (PG8_LAS unsigned*)((PG8_LAS unsigned char*)lds + AT_Q + w * 8192 + (qg * 2 + ks) * 1024), 16, 0, 0);
        gload(c_lo);
        asm volatile("s_waitcnt vmcnt(0)" ::: "memory");
        {
            float gq[2][8];
#pragma unroll
            for (int ks = 0; ks < 2; ++ks)
#pragma unroll
                for (int j = 0; j < 8; ++j) gq[ks][j] = P.q_gain[32 * ks + 8 * fq + j] * (0.125f * LOG2E);
#pragma unroll 1
            for (int qg = 0; qg < 4; ++qg) {
                const u32x4 r0 = __builtin_bit_cast(u32x4, Qs[(qg * 2 + 0) * 64]), r1 = __builtin_bit_cast(u32x4, Qs[(qg * 2 + 1) * 64]);
                float f[2][8]; float ss = 0.f;
#pragma unroll
                for (int e = 0; e < 4; ++e) { f[0][2 * e] = bflo(r0[e]); f[0][2 * e + 1] = bfhi(r0[e]); f[1][2 * e] = bflo(r1[e]); f[1][2 * e + 1] = bfhi(r1[e]); }
#pragma unroll
                for (int j = 0; j < 8; ++j) ss += f[0][j] * f[0][j] + f[1][j] * f[1][j];
                ss += __shfl_xor(ss, 16); ss += __shfl_xor(ss, 32);
                const float rn = 1.0f / sqrtf(ss * (1.f / 64) + EPS);
#pragma unroll
                for (int ks = 0; ks < 2; ++ks) { u32x4 o;
#pragma unroll
                    for (int e = 0; e < 4; ++e) o[e] = pk2(f[ks][2 * e] * rn * gq[ks][2 * e], f[ks][2 * e + 1] * rn * gq[ks][2 * e + 1]);
                    Qs[(qg * 2 + ks) * 64] = __builtin_bit_cast(bf16x8, o); }
            }
        }
        const float sinkp = __builtin_amdgcn_exp2f(P.sink[h] * LOG2E - ((const float*)(P.ws + OFF_M0))[h]);
        f32x4 O[4][4]; float lrow[4];
#pragma unroll
        for (int qg = 0; qg < 4; ++qg) { lrow[qg] = (fq == 0) ? sinkp : 0.f;
#pragma unroll
            for (int dt = 0; dt < 4; ++dt) O[qg][dt] = (f32x4){0.f, 0.f, 0.f, 0.f}; }
        auto lstore = [&](int buf) {
            float f[8]; float ss = 0.f; float gk[8];
#pragma unroll
            for (int j = 0; j < 8; ++j) gk[j] = P.k_gain[8 * (tid & 7) + j];
#pragma unroll
            for (int e = 0; e < 4; ++e) { f[2 * e] = bflo(kreg[e]); f[2 * e + 1] = bfhi(kreg[e]); }
#pragma unroll
            for (int j = 0; j < 8; ++j) ss += f[j] * f[j];
            ss += __shfl_xor(ss, 1); ss += __shfl_xor(ss, 2); ss += __shfl_xor(ss, 4);
            const float rn = 1.0f / sqrtf(ss * (1.f / 64) + EPS);
            u32x4 o;
#pragma unroll
            for (int e = 0; e < 4; ++e) o[e] = pk2(f[2 * e] * rn * gk[2 * e], f[2 * e + 1] * rn * gk[2 * e + 1]);
            *(u32x4*)(lds + AT_K + buf * (64 * KST * 2) + ((tid >> 3) * KST + 8 * (tid & 7)) * 2) = o;
            bf16* vt = (bf16*)(lds + AT_V + buf * (64 * KST * 2));
#pragma unroll
            for (int e = 0; e < 4; ++e) { vt[(8 * w + 2 * e) * KST + lane] = (bf16)(vreg[e] & 0xffffu); vt[(8 * w + 2 * e + 1) * KST + lane] = (bf16)(vreg[e] >> 16); }
        };
        lstore(0);
        __syncthreads();
        for (int c = c_lo; c < c_hi; ++c) {
            const int buf = (c - c_lo) & 1;
            if (c + 1 < c_hi) gload(c + 1);
            const bool skip = (qh == 0 && c == 5) || (qh == 1 && c == 0);
            if (!skip) {
                const unsigned char* kb = lds + AT_K + buf * (64 * KST * 2);
                const unsigned char* vb = lds + AT_V + buf * (64 * KST * 2);
                bf16x8 Kf[4][2];
#pragma unroll
                for (int t = 0; t < 4; ++t)
#pragma unroll
                    for (int ks = 0; ks < 2; ++ks) Kf[t][ks] = *(const bf16x8*)(kb + ((16 * t + fr) * KST + 32 * ks + 8 * fq) * 2);
#pragma unroll
                for (int qg = 0; qg < 4; ++qg) {
                    f32x4 S[4];
                    __builtin_amdgcn_sched_barrier(0);
                    const bf16x8 Qf0 = Qs[(qg * 2 + 0) * 64], Qf1 = Qs[(qg * 2 + 1) * 64];
                    __builtin_amdgcn_s_setprio(1);
#pragma unroll
                    for (int t = 0; t < 4; ++t) { S[t] = (f32x4){0.f, 0.f, 0.f, 0.f};
#pragma unroll
                        for (int ks = 0; ks < 2; ++ks) S[t] = __builtin_amdgcn_mfma_f32_16x16x32_bf16(Kf[t][ks], ks == 0 ? Qf0 : Qf1, S[t], 0, 0, 0); }
                    __builtin_amdgcn_s_setprio(0);
                    const int q = 64 * qh + 16 * qg + fr;
                    const float* tbp = tb + g * 512 + (64 * c - 128 + 4 * fq - q + 255);
                    float rs = 0.f;
#pragma unroll
                    for (int t = 0; t < 4; ++t)
#pragma unroll
                        for (int j = 0; j < 4; ++j) { S[t][j] = __builtin_amdgcn_exp2f(S[t][j] + tbp[16 * t + j]); rs += S[t][j]; }
                    lrow[qg] += rs;
                    bf16x8 Pf[2];
#pragma unroll
                    for (int s = 0; s < 2; ++s) { u32x4 o; o.x = pk2(S[2 * s][0], S[2 * s][1]); o.y = pk2(S[2 * s][2], S[2 * s][3]); o.z = pk2(S[2 * s + 1][0], S[2 * s + 1][1]); o.w = pk2(S[2 * s + 1][2], S[2 * s + 1][3]);
                        Pf[s] = __builtin_bit_cast(bf16x8, o); }
                    __builtin_amdgcn_sched_barrier(0);
                    __builtin_amdgcn_s_setprio(1);
#pragma unroll
                    for (int dt = 0; dt < 4; ++dt)
#pragma unroll
                        for (int s = 0; s < 2; ++s) { const s16x4 lo = *(const s16x4*)(vb + ((16 * dt + fr) * KST + 32 * s + 4 * fq) * 2), hi = *(const s16x4*)(vb + ((16 * dt + fr) * KST + 32 * s + 16 + 4 * fq) * 2);
                            const bf16x8 Vf = (bf16x8){lo[0], lo[1], lo[2], lo[3], hi[0], hi[1], hi[2], hi[3]};
                            O[qg][dt] = __builtin_amdgcn_mfma_f32_16x16x32_bf16(Vf, Pf[s], O[qg][dt], 0, 0, 0); }
                    __builtin_amdgcn_s_setprio(0);
                }
            }
            if (c + 1 < c_hi) lstore(buf ^ 1);
            __syncthreads();
        }
        u32x2 gv[4][4];
#pragma unroll
        for (int qg = 0; qg < 4; ++qg)
#pragma unroll
            for (int dt = 0; dt < 4; ++dt) gv[qg][dt] = *(const u32x2*)(GATES + (m0 + 64 * qh + 16 * qg + fr) * LDG + h * 64 + 16 * dt + 4 * fq);
#pragma unroll
        for (int qg = 0; qg < 4; ++qg) {
            float lt = lrow[qg]; lt += __shfl_xor(lt, 16); lt += __shfl_xor(lt, 32);
            const float inv = 1.0f / lt;
            const size_t row = m0 + 64 * qh + 16 * qg + fr;
#pragma unroll
            for (int dt = 0; dt < 4; ++dt) { const int col = h * 64 + 16 * dt + 4 * fq;
                const f32x4 o = O[qg][dt] * inv;
                *(u32x2*)(QKVU + row * LDQ + col) = (u32x2){pk2(o[0] * bflo(gv[qg][dt].x), o[1] * bfhi(gv[qg][dt].x)), pk2(o[2] * bflo(gv[qg][dt].y), o[3] * bfhi(gv[qg][dt].y))}; }
        }
    }
}

constexpr int SS_TOT = 131072;
__device__ __forceinline__ float gelu_tanh(float x) {
    const float t = x + 0.044715f * x * x * x;
    return x * __builtin_amdgcn_rcpf(1.0f + __builtin_amdgcn_exp2f(-2.0f * 0.7978845608028654f * LOG2E * t));
}
__device__ __forceinline__ f32x2 gelu_tanh2(f32x2 x) {
    const f32x2 x2 = x * x, t = x * (x2 * 0.044715f + 1.0f), a = t * (-2.0f * 0.7978845608028654f * LOG2E);
    f32x2 e; e.x = __builtin_amdgcn_exp2f(a.x); e.y = __builtin_amdgcn_exp2f(a.y);
    const f32x2 d = e + 1.0f; f32x2 r; r.x = __builtin_amdgcn_rcpf(d.x); r.y = __builtin_amdgcn_rcpf(d.y);
    return x * r;
}
__device__ __forceinline__ f32x2 cmul(f32x2 a, f32x2 b);
template <int DIR>
__device__ __forceinline__ void ssm_emit(f32x4 y, u32x2 ulo, unsigned long long ybv, f32x4 dsk, u32x2* yp) {
    if (DIR == 1) { *yp = (u32x2){pk2(y[0], y[1]), pk2(y[2], y[3])}; }
    else {
        const unsigned yl = (unsigned)ybv, yh = (unsigned)(ybv >> 32);
        const f32x2 ya = (f32x2){y[0], y[1]} + (f32x2){bflo(yl), bfhi(yl)} + (f32x2){dsk[0], dsk[1]} * (f32x2){bflo(ulo.x), bfhi(ulo.x)};
        const f32x2 yb = (f32x2){y[2], y[3]} + (f32x2){bflo(yh), bfhi(yh)} + (f32x2){dsk[2], dsk[3]} * (f32x2){bflo(ulo.y), bfhi(ulo.y)};
        *yp = (u32x2){pk2v(gelu_tanh2(ya)), pk2v(gelu_tanh2(yb))};
    }
}
template <int DIR, bool OUT>
__device__ __forceinline__ void ssm_pair(const bf16x8 (&Bf2)[4][2], const bf16x8 (&Cf)[4], const bf16x8 (&CAf)[4], s16x4 K0f, const f32x2 (&a2r)[4][2], const f32x2 (&a2i)[4][2],
                                         f32x2 (&hr)[4][2], f32x2 (&hi)[4][2], bf16x8 (&hB)[4], u32x2 u1, u32x2 u2, unsigned long long yb1, unsigned long long yb2, f32x4 dsk, u32x2* yp1, u32x2* yp2) {
    const f32x4 z = (f32x4){0.f, 0.f, 0.f, 0.f};
    f32x4 y1 = z;
    __builtin_amdgcn_s_setprio(1);
    if (OUT) {
        const u32x2 k0_ = __builtin_bit_cast(u32x2, K0f);
        y1 = __builtin_amdgcn_mfma_f32_16x16x32_bf16(__builtin_bit_cast(bf16x8, ((u32x4){k0_.x, k0_.y, 0u, 0u})), __builtin_bit_cast(bf16x8, ((u32x4){u1.x, u1.y, 0u, 0u})), z, 0, 0, 0);
#pragma unroll
        for (int s = 0; s < 4; ++s) y1 = __builtin_amdgcn_mfma_f32_16x16x32_bf16(CAf[s], hB[s], y1, 0, 0, 0); }
    const bf16x8 uB = __builtin_bit_cast(bf16x8, ((u32x4){u1.x, u1.y, u2.x, u2.y}));
#pragma unroll
    for (int pt = 0; pt < 4; ++pt) {
        const f32x4 br = __builtin_amdgcn_mfma_f32_16x16x32_bf16(Bf2[pt][0], uB, z, 0, 0, 0);
        const f32x4 bi = __builtin_amdgcn_mfma_f32_16x16x32_bf16(Bf2[pt][1], uB, z, 0, 0, 0);
        if (pt == 3) __builtin_amdgcn_s_setprio(0);
#pragma unroll
        for (int jj = 0; jj < 2; ++jj) { const f32x2 brp = (f32x2){br[2 * jj], br[2 * jj + 1]}, bip = (f32x2){bi[2 * jj], bi[2 * jj + 1]}, r0 = hr[pt][jj], i0 = hi[pt][jj];
            hr[pt][jj] = a2r[pt][jj] * r0 - a2i[pt][jj] * i0 + brp;
            hi[pt][jj] = a2r[pt][jj] * i0 + a2i[pt][jj] * r0 + bip; }
    }
    if (!OUT) return;
    ssm_emit<DIR>(y1, u1, yb1, dsk, yp1);
    f32x4 y2 = z;
#pragma unroll
    for (int s = 0; s < 4; ++s) { const int p0 = 2 * (s & 1); u32x4 o;
        if (s < 2) { o.x = pk2v(hr[p0][0]); o.y = pk2v(hr[p0][1]); o.z = pk2v(hr[p0 + 1][0]); o.w = pk2v(hr[p0 + 1][1]); }
        else       { o.x = pk2v(hi[p0][0]); o.y = pk2v(hi[p0][1]); o.z = pk2v(hi[p0 + 1][0]); o.w = pk2v(hi[p0 + 1][1]); }
        hB[s] = __builtin_bit_cast(bf16x8, o);
        y2 = __builtin_amdgcn_mfma_f32_16x16x32_bf16(Cf[s], hB[s], y2, 0, 0, 0); }
    ssm_emit<DIR>(y2, u2, yb2, dsk, yp2);
}
template <int DIR, bool OUT>
__device__ __forceinline__ void ssm_pass2(const Params& P, const bf16* UG, bf16* YP, bf16* Y, f32x2* EP, int seq, int g, int q, int fr_in, int fq_in) {
    int fr = fr_in, fq = fq_in; asm volatile("" : "+v"(fr), "+v"(fq));
    const int dg = DIR * 64 + g;
    const bf16* BB = (const bf16*)(P.ws + OFF_BB); const bf16* BBA = (const bf16*)(P.ws + OFF_BBA); const f32x2* AP = (const f32x2*)(P.ws + OFF_AP);
    const bf16* CF = (const bf16*)(P.ws + OFF_CF); const bf16* CAF = (const bf16*)(P.ws + OFF_CAF); const bf16* K0 = (const bf16*)(P.ws + OFF_K0);
    bf16x8 Bf2[4][2], Cf[4], CAf[4], hB[4]; f32x2 a2r[4][2], a2i[4][2], hr[4][2], hi[4][2];
#pragma unroll
    for (int pt = 0; pt < 4; ++pt) {
#pragma unroll
        for (int ri = 0; ri < 2; ++ri) { const size_t o_ = ((size_t)(dg * 2 + ri) * 64 + 16 * pt + fr) * 16 + 4 * fq; const u32x2 lo = *(const u32x2*)(BBA + o_), hi2 = *(const u32x2*)(BB + o_);
            Bf2[pt][ri] = __builtin_bit_cast(bf16x8, ((u32x4){lo.x, lo.y, hi2.x, hi2.y})); }
#pragma unroll
        for (int jj = 0; jj < 2; ++jj) { const f32x2 a0 = AP[dg * 64 + 16 * pt + 4 * fq + 2 * jj], a1 = AP[dg * 64 + 16 * pt + 4 * fq + 2 * jj + 1], s0 = cmul(a0, a0), s1 = cmul(a1, a1);
            a2r[pt][jj] = (f32x2){s0.x, s1.x}; a2i[pt][jj] = (f32x2){s0.y, s1.y};
            if (OUT) { const f32x2 e0 = EP[DIR * 1024 + (16 * pt + 4 * fq + 2 * jj) * 16 + fr], e1 = EP[DIR * 1024 + (16 * pt + 4 * fq + 2 * jj + 1) * 16 + fr]; hr[pt][jj] = (f32x2){e0.x, e1.x}; hi[pt][jj] = (f32x2){e0.y, e1.y}; }
            else { hr[pt][jj] = (f32x2){0.f, 0.f}; hi[pt][jj] = (f32x2){0.f, 0.f}; } }
    }
#pragma unroll
    for (int s = 0; s < 4; ++s) { if (!OUT) { Cf[s] = (bf16x8){0, 0, 0, 0, 0, 0, 0, 0}; CAf[s] = Cf[s]; hB[s] = Cf[s]; continue; }
        Cf[s] = *(const bf16x8*)(CF + (size_t)dg * 2048 + ((s * 16 + fr) * 4 + fq) * 8); CAf[s] = *(const bf16x8*)(CAF + (size_t)dg * 2048 + ((s * 16 + fr) * 4 + fq) * 8);
        const int p0 = 2 * (s & 1); u32x4 o;
        if (s < 2) { o.x = pk2v(hr[p0][0]); o.y = pk2v(hr[p0][1]); o.z = pk2v(hr[p0 + 1][0]); o.w = pk2v(hr[p0 + 1][1]); }
        else       { o.x = pk2v(hi[p0][0]); o.y = pk2v(hi[p0][1]); o.z = pk2v(hi[p0 + 1][0]); o.w = pk2v(hi[p0 + 1][1]); }
        hB[s] = __builtin_bit_cast(bf16x8, o); }
    s16x4 K0f = (s16x4){0, 0, 0, 0}; if (OUT) K0f = *(const s16x4*)(K0 + (size_t)dg * 256 + fr * 16 + 4 * fq);
    f32x4 dsk = (f32x4){0.f, 0.f, 0.f, 0.f};
    if (OUT && DIR == 0) dsk = *(const f32x4*)(P.d_skip + 16 * g + 4 * fq);
    const size_t rowu = (size_t)seq * L + 64 * 16 * q;
    const bf16* Ub = UG + ((size_t)g * M + rowu) * 16;
    bf16* Pb = YP + ((size_t)g * M + rowu) * 16;
    bf16* Yb = Y + rowu * D + 16 * g;
    const unsigned og = (unsigned)(64 * fr * 16 + 4 * fq) / 4, oy = (unsigned)(64 * fr * D + 4 * fq) / 4;
    constexpr bool NEEDY = OUT && DIR == 0;
    u32x2 bU[2][4]; unsigned long long bY[2][4];
#define TAU(st) (DIR == 0 ? (st) : 63 - (st))
#define SSM_LOAD(B, blk) do { _Pragma("unroll") for (int k_ = 0; k_ < 4; ++k_) { const int tau_ = TAU((blk) * 4 + k_); \
        bU[B][k_] = ((const u32x2*)(Ub + (size_t)tau_ * 16))[og]; \
        if (NEEDY) bY[B][k_] = __hip_atomic_load((const unsigned long long*)(Pb + (size_t)tau_ * 16) + og, __ATOMIC_RELAXED, __HIP_MEMORY_SCOPE_AGENT); } } while (0)
#define YPTR(st) (DIR == 1 ? (u32x2*)(Pb + (size_t)TAU(st) * 16) + og : (u32x2*)(Yb + (size_t)TAU(st) * D) + oy)
#define SSM_PAIRS(B, blk) do { _Pragma("unroll") for (int k_ = 0; k_ < 4; k_ += 2) { const int st_ = (blk) * 4 + k_; __builtin_amdgcn_sched_barrier(0); \
        ssm_pair<DIR, OUT>(Bf2, Cf, CAf, K0f, a2r, a2i, hr, hi, hB, bU[B][k_], bU[B][k_ + 1], NEEDY ? bY[B][k_] : 0ull, NEEDY ? bY[B][k_ + 1] : 0ull, dsk, YPTR(st_), YPTR(st_ + 1)); } } while (0)
    SSM_LOAD(0, 0);
#pragma unroll 1
    for (int b = 0; b < 16; b += 2) {
        SSM_LOAD(1, b + 1);
        __builtin_amdgcn_sched_barrier(0);
        SSM_PAIRS(0, b);
        if (b + 2 < 16) SSM_LOAD(0, b + 2);
        __builtin_amdgcn_sched_barrier(0);
        SSM_PAIRS(1, b + 1);
    }
#undef SSM_LOAD
#undef SSM_PAIRS
#undef YPTR
#undef TAU
    if (!OUT) {
#pragma unroll
        for (int pt = 0; pt < 4; ++pt)
#pragma unroll
            for (int jj = 0; jj < 2; ++jj) { EP[DIR * 1024 + (16 * pt + 4 * fq + 2 * jj) * 16 + fr] = (f32x2){hr[pt][jj].x, hi[pt][jj].x}; EP[DIR * 1024 + (16 * pt + 4 * fq + 2 * jj + 1) * 16 + fr] = (f32x2){hr[pt][jj].y, hi[pt][jj].y}; }
    }
    asm volatile("s_waitcnt vmcnt(0) lgkmcnt(0)" ::: "memory");
}
__device__ __forceinline__ f32x2 cmul(f32x2 a, f32x2 b) { return (f32x2){a.x * b.x - a.y * b.y, a.x * b.y + a.y * b.x}; }
template <int DIR>
__device__ __forceinline__ f32x2 ssm_carry1(f32x2* EPd, f32x2 aT, int lane) {
    f32x2 e[16];
#pragma unroll
    for (int kk = 0; kk < 16; ++kk) e[kk] = EPd[lane * 16 + kk];
    f32x2 acc = (f32x2){0.f, 0.f};
#pragma unroll
    for (int i = 0; i < 16; ++i) { const int kk = DIR == 0 ? i : 15 - i; EPd[lane * 16 + kk] = acc; acc = cmul(aT, acc) + e[kk]; }
    return acc;
}
template <int DIR>
__device__ __forceinline__ void ssm_carry2(f32x2* EPd, f32x2 aT, f32x2 Hq, int lane) {
    f32x2 e[16];
#pragma unroll
    for (int kk = 0; kk < 16; ++kk) e[kk] = EPd[lane * 16 + kk];
    f32x2 pw = Hq;
#pragma unroll
    for (int i = 0; i < 16; ++i) { const int kk = DIR == 0 ? i : 15 - i; EPd[lane * 16 + kk] = e[kk] + pw; pw = cmul(aT, pw); }
}
__device__ __forceinline__ void ssm_phase(const Params& P, unsigned char* lds, int tid, int w, int lane) {
    const bf16* UG = (const bf16*)(P.ws + OFF_UG);
    bf16* Y = (bf16*)(P.ws + OFF_Y); bf16* YP = (bf16*)(P.ws + OFF_XB);
    const int fr = lane & 15, fq = lane >> 4, q = w & 3, ps = w >> 2;
    f32x2* EP = (f32x2*)(lds + w * 16384);
    f32x2* TOT = (f32x2*)(lds + SS_TOT);
    const f32x2* AT = (const f32x2*)(P.ws + OFF_AT); const f32x2* AT16 = (const f32x2*)(P.ws + OFF_AT16);
    for (int couple = blockIdx.x; couple < NSEQ * 64 / 2; couple += gridDim.x) {
        const int pair = couple * 2 + ps, seq = pair >> 6, g = pair & 63;
        __syncthreads();
        for (int rep = 0; rep < REPS(3); ++rep) {
        ssm_pass2<1, false>(P, UG, YP, Y, EP, seq, g, q, fr, fq);
        ssm_pass2<0, false>(P, UG, YP, Y, EP, seq, g, q, fr, fq); }
        const f32x2 aTf = AT[(0 * 64 + g) * 64 + lane], aTb = AT[(1 * 64 + g) * 64 + lane], aT16f = AT16[(0 * 64 + g) * 64 + lane], aT16b = AT16[(1 * 64 + g) * 64 + lane];
        TOT[((ps * 2 + 0) * 4 + q) * 64 + lane] = ssm_carry1<0>(EP, aTf, lane);
        TOT[((ps * 2 + 1) * 4 + q) * 64 + lane] = ssm_carry1<1>(EP + 1024, aTb, lane);
        __syncthreads();
        { f32x2 Hf = (f32x2){0.f, 0.f}, Hb = (f32x2){0.f, 0.f};
            for (int qq = 0; qq < q; ++qq) Hf = cmul(aT16f, Hf) + TOT[((ps * 2 + 0) * 4 + qq) * 64 + lane];
            for (int qq = 3; qq > q; --qq) Hb = cmul(aT16b, Hb) + TOT[((ps * 2 + 1) * 4 + qq) * 64 + lane];
            ssm_carry2<0>(EP, aTf, Hf, lane); ssm_carry2<1>(EP + 1024, aTb, Hb, lane); }
        asm volatile("s_waitcnt lgkmcnt(0)" ::: "memory");
        ssm_pass2<1, true>(P, UG, YP, Y, EP, seq, g, q, fr, fq);
        ssm_pass2<0, true>(P, UG, YP, Y, EP, seq, g, q, fr, fq);
    }
}

#define LAS __attribute__((address_space(3)))
constexpr size_t OFF_BAR = 458752;
constexpr int LDS_MISC_OFF = LDS_BYTES - 16;
#define XB_TMO      128
#define XB_XCNT(j)  (256  + 64 * (j))
#define XB_XSUB(j)  (1280 + 64 * (j))
#define XB_XGEN(j)  (2304 + 64 * (j))
#define XB_TOP      3328
#define XB_TOPGEN   3392
#define XCD_BAR_WORDS 3456
#define XB_SPIN_CAP (1u << 18)

__device__ __forceinline__ unsigned xb_ld(unsigned* p)              { return __hip_atomic_load(p, __ATOMIC_RELAXED, __HIP_MEMORY_SCOPE_AGENT); }
__device__ __forceinline__ unsigned xb_add(unsigned* p, unsigned v) { return __hip_atomic_fetch_add(p, v, __ATOMIC_RELAXED, __HIP_MEMORY_SCOPE_AGENT); }
__device__ __forceinline__ unsigned xb_xcc_id() { return (unsigned)__builtin_amdgcn_s_getreg((3 << 11) | 20) & 0xFu; }
#define XB_SPIN(cond, bar) do { unsigned _sp = 0; while (cond) { __builtin_amdgcn_s_sleep(1); \
    if ((++_sp & 255u) == 0u) { if (xb_ld(&(bar)[XB_TMO])) break; if (_sp > XB_SPIN_CAP) { atomicAdd(&(bar)[XB_TMO], 1u); break; } } } } while (0)

struct XcdBarrier {
    unsigned* bar; unsigned x;
    volatile LAS unsigned* st;
};

__device__ __forceinline__ XcdBarrier xcd_barrier_post(unsigned* bar, volatile LAS unsigned* st) {
    XcdBarrier b; b.bar = bar; b.x = xb_xcc_id(); b.st = st;
    if (threadIdx.x == 0) (void)xb_add(&bar[XB_XCNT(b.x)], 1u);
    return b;
}
__device__ __forceinline__ void xcd_barrier_complete(unsigned* bar, unsigned x, unsigned& nloc, unsigned& nx) {
    const unsigned G = gridDim.x * gridDim.y * gridDim.z;
    unsigned sum, cnt, mine, sp = 0u;
    for (;;) {
        sum = 0u; cnt = 0u; mine = 0u;
#pragma unroll
        for (unsigned j = 0; j < 16; ++j) { const unsigned c = xb_ld(&bar[XB_XCNT(j)]); sum += c; cnt += (c > 0u) ? 1u : 0u; mine = (j == x) ? c : mine; }
        if (sum == G) break;
        __builtin_amdgcn_s_sleep(1);
        if ((++sp & 255u) == 0u) { if (xb_ld(&bar[XB_TMO])) break; if (sp > XB_SPIN_CAP) { atomicAdd(&bar[XB_TMO], 1u); break; } }
    }
    nloc = mine > 0u ? mine : 1u; nx = cnt > 0u ? cnt : 1u;
}

__device__ __forceinline__ void xcd_barrier(const XcdBarrier& b) {
    asm volatile("s_waitcnt vmcnt(0)" ::: "memory");
    __syncthreads();
    if (threadIdx.x == 0) {
        unsigned* bar = b.bar;
        __builtin_amdgcn_s_waitcnt(0);
        unsigned nloc = b.st[0], nx = b.st[1];
        if (nloc == 0u) { xcd_barrier_complete(bar, b.x, nloc, nx); b.st[0] = nloc; b.st[1] = nx; }
        const unsigned old = xb_add(&bar[XB_XSUB(b.x)], 1u);
        const unsigned gen = old / nloc;
        if (old + 1u == (gen + 1u) * nloc) {
            __builtin_amdgcn_fence(__ATOMIC_RELEASE, "agent");
            asm volatile("s_waitcnt vmcnt(0)" ::: "memory");
            const unsigned og = xb_add(&bar[XB_TOP], 1u);
            const unsigned tg = og / nx;
            if (og + 1u == (tg + 1u) * nx) xb_add(&bar[XB_TOPGEN], 1u);
            else XB_SPIN(xb_ld(&bar[XB_TOPGEN]) == tg, bar);
            __builtin_amdgcn_fence(__ATOMIC_ACQUIRE, "agent");
            xb_add(&bar[XB_XGEN(b.x)], 1u);
            asm volatile("s_waitcnt vmcnt(0)" ::: "memory");
        } else {
            XB_SPIN(xb_ld(&bar[XB_XGEN(b.x)]) == gen, bar);
            __builtin_amdgcn_fence(__ATOMIC_ACQUIRE, "agent");
            asm volatile("s_waitcnt vmcnt(0)" ::: "memory");
        }
    }
    __syncthreads();
}

__global__ void __launch_bounds__(512, 2) fwd_megakernel(Params P) {
    extern __shared__ __attribute__((aligned(16))) unsigned char lds[];
    cg::grid_group grid = cg::this_grid();
    const int tid = threadIdx.x, lane = tid & 63, wave = __builtin_amdgcn_readfirstlane(tid >> 6);
    unsigned char* ws = P.ws;
    const int lo = P.ph_lo, hi = P.ph_hi;
#ifndef PHMASK
#define PHMASK 255
#endif
#define IN(k) (((PHMASK >> (k)) & 1) && lo <= (k) && (k) < hi)
#define SEAM(k) do { if (IN(k) && IN((k) + 1)) xcd_barrier(bar); } while (0)
    volatile LAS unsigned* MISC = (volatile LAS unsigned*)((LAS unsigned char*)lds + LDS_MISC_OFF);
    if (tid < 2) MISC[tid] = 0u;
    __syncthreads();
    const XcdBarrier bar = xcd_barrier_post((unsigned*)(ws + OFF_BAR), MISC);
    if (hi < 0) grid.sync();
    PG8_LAS unsigned char* ring = (PG8_LAS unsigned char*)lds;
    bf16* XB = (bf16*)(ws + OFF_XB); bf16* QKVU = (bf16*)(ws + OFF_QKVU); bf16* Y = (bf16*)(ws + OFF_Y); bf16* UPB = (bf16*)(ws + OFF_UP);
    bf16* GATES = (bf16*)P.out; float* ss2 = (float*)(ws + OFF_SS2);
    if (IN(0)) { for (int rep = 0; rep < REPS(0); ++rep) { p0_prologue(P, lds, tid, wave, lane); __syncthreads(); } }
    SEAM(0);
#ifdef EXTRA_SYNCS
    for (int i_ = 0; i_ < EXTRA_SYNCS; ++i_) xcd_barrier(bar);
#endif
    if (IN(1)) {
        pg8::Gemm gm{XB, (const bf16*)(ws + OFF_WIN), M, NIN, D}; pg8::StaticOrder S; S.init(M, NIN, gridDim.x, (int)blockIdx.x);
        EpiProj E{QKVU, (bf16*)(ws + OFF_UG), GATES};
        for (int rep = 0; rep < REPS(1); ++rep)
        pg8::gemm_phase<EpiProj, pg8::StaticOrder, true, true>(ring, gm, S, E);
    }
    SEAM(1);
    if (IN(2)) {
        attn_phase(P, lds, tid, wave, lane); __syncthreads();
        for (int rep = 0; rep < REPS(2); ++rep) ssm_phase(P, lds, tid, wave, lane);
    }
    SEAM(2);
    if (IN(4)) {
        pg8::Gemm gm{Y, (const bf16*)(ws + OFF_WGLU), M, D, D}; pg8::StaticOrder S; S.init(M, D, gridDim.x, (int)blockIdx.x);
        EpiGlu E{Y, QKVU, GATES + 1024, P.b_glu, XB};
        for (int rep = 0; rep < REPS(4); ++rep)
        pg8::gemm_phase<EpiGlu, pg8::StaticOrder, true, true>(ring, gm, S, E);
    }
    SEAM(4);
    if (IN(5)) {
        pg8::Gemm gm{XB, (const bf16*)(ws + OFF_WOUT), M, D, D}; pg8::StaticOrder S; S.init(M, D, gridDim.x, (int)blockIdx.x);
        EpiOut E{P.xp, P.xs, P.out, Y, ss2};
        pg8::gemm_phase<EpiOut, pg8::StaticOrder, true, true>(ring, gm, S, E);
    }
    SEAM(5);
    if (IN(6)) {
        pg8::Gemm gm{Y, (const bf16*)(ws + OFF_WUP), M, FF, D}; pg8::StaticOrder S; S.init(M, FF, gridDim.x, (int)blockIdx.x);
        EpiUp E{ss2, UPB};
        for (int rep = 0; rep < REPS(6); ++rep)
        pg8::gemm_phase<EpiUp, pg8::StaticOrder, true, true>(ring, gm, S, E);
    }
    SEAM(6);
    if (IN(7)) {
        pg8::Gemm gm{UPB, (const bf16*)(ws + OFF_WDN), M, D, FF}; pg8::StaticOrder S; S.init(M, D, gridDim.x, (int)blockIdx.x);
        EpiDown E{P.out};
        pg8::gemm_phase<EpiDown, pg8::StaticOrder, true, true>(ring, gm, S, E);
    }
#undef IN
#undef SEAM
}

#ifndef MK_N_LAUNCHES
#define MK_N_LAUNCHES 1
#endif
extern "C" void kernel_launch(void* const* d_in, const int* in_sizes, int n_in, void* d_out, int out_size, void* d_ws, size_t ws_size, hipStream_t stream) {
    static int grid = 0;
    if (grid == 0) {
        if (n_in != 22 || out_size != M * D || ws_size < WS_NEED) { fprintf(stderr, "kernel_launch: unexpected shapes (n_in %d out %d ws %zu)\n", n_in, out_size, ws_size); grid = -1; return; }
        int dev = 0, cus = 0, per_cu = 0;
        hipGetDevice(&dev); hipDeviceGetAttribute(&cus, hipDeviceAttributeMultiprocessorCount, dev);
        if (hipFuncSetAttribute((const void*)fwd_megakernel, hipFuncAttributeMaxDynamicSharedMemorySize, LDS_BYTES) != hipSuccess) { fprintf(stderr, "kernel_launch: hipFuncSetAttribute failed\n"); grid = -1; return; }
        if (hipOccupancyMaxActiveBlocksPerMultiprocessor(&per_cu, (const void*)fwd_megakernel, 512, LDS_BYTES) != hipSuccess || per_cu < 1) { fprintf(stderr, "kernel_launch: occupancy query says %d\n", per_cu); per_cu = 1; }
        (void)hipGetLastError();
        grid = cus;
    }
    if (grid < 0) return;
    Params p{};
    const float** f = &p.xp;
    for (int i = 0; i < 22; ++i) f[i] = (const float*)d_in[i];
    p.out = (float*)d_out; p.ws = (unsigned char*)d_ws;
    if (hipMemsetAsync((char*)d_ws + OFF_BAR, 0, 16384, stream) != hipSuccess) { fprintf(stderr, "kernel_launch: hipMemsetAsync failed\n"); return; }
    if (MK_N_LAUNCHES == 1) {
        p.ph_lo = 0; p.ph_hi = 8;
        void* args[] = {&p};
        hipError_t e = hipLaunchCooperativeKernel((const void*)fwd_megakernel, dim3(grid), dim3(512), args, LDS_BYTES, stream);
        if (e != hipSuccess) fprintf(stderr, "cooperative launch failed: %s (grid %d)\n", hipGetErrorString(e), grid);
    } else {
        for (int ph = 0; ph < 8; ++ph) { p.ph_lo = ph; p.ph_hi = ph + 1;
            void* args[] = {&p};
            hipError_t e = hipLaunchCooperativeKernel((const void*)fwd_megakernel, dim3(grid), dim3(512), args, LDS_BYTES, stream);
            if (e != hipSuccess) { fprintf(stderr, "launch %d failed: %s\n", ph, hipGetErrorString(e)); break; } }
    }
}
```

```cpp
#include <hip/hip_runtime.h>
#include <hip/hip_cooperative_groups.h>
#include <cstdio>
#include <cstdint>
namespace cg = cooperative_groups;
namespace pg8 {
#define PG8_LAS __attribute__((address_space(3)))
typedef unsigned short bf16_t;
typedef short bf16x8 __attribute__((ext_vector_type(8)));
typedef float f32x4 __attribute__((ext_vector_type(4)));
typedef unsigned u32x4 __attribute__((ext_vector_type(4)));
constexpr int BM = 256, BK = 64, HALF = 128, HTB = HALF * BK * 2  , STAGE_BYTES = 8 * HTB, NXCD = 8, WGM = 8;

__host__ __device__ __forceinline__ int lds_byte(int r, int c) { const int st = (r >> 4) * 2 + (c >> 5), rr = r & 15, cc = c & 31, ob = rr * 64 + cc * 2; return st * 1024 + (ob ^ (((ob >> 9) & 1) << 5)); }
__host__ __device__ __forceinline__ void stage_rc(int b, int& R, int& C) { const int st = b / 1024, sb = b % 1024, swz = sb ^ (((sb >> 9) & 1) << 5); R = (st >> 1) * 16 + swz / 64; C = (st & 1) * 32 + (swz % 64) / 2; }
__host__ __device__ __forceinline__ int perm32(int rho) { const int n = rho >> 4, i = rho & 15; return 8 * (i >> 2) + 4 * n + (i & 3); }

struct Unit { int pm, pn; };
struct Gemm { const bf16_t* A; const bf16_t* Bt; int M, N, K; };

struct StaticOrder {
    int nM, nN, nwg, G, c;
    __host__ __device__ void init(int M, int N, int G_, int c_) { nM = M / BM; nN = N / BM; nwg = nM * nN; G = G_; c = c_; }
    __host__ __device__ bool next(int i, Unit& u) const {
        const long L = (long)i * G + c; if (L >= nwg) return false;
        int wgid = (int)L; { const int q = nwg / NXCD, r = nwg % NXCD, xcd = wgid % NXCD, off = wgid / NXCD; wgid = (xcd < r ? xcd * (q + 1) : r * (q + 1) + (xcd - r) * q) + off; }
        const int nig = WGM * nN, gid = wgid / nig, fm = gid * WGM, gsz = (nM - fm) < WGM ? (nM - fm) : WGM;
        u.pm = fm + ((wgid % nig) % gsz); u.pn = (wgid % nig) / gsz; return true;
    }
    __device__ __forceinline__ void a_ready(const Unit&) const {}
    __device__ __forceinline__ void done(const Unit&) const {}
};
__device__ __forceinline__ unsigned cvt_pk_bf16(float lo, float hi) { unsigned r; asm volatile("v_cvt_pk_bf16_f32 %0, %1, %2" : "=v"(r) : "v"(lo), "v"(hi)); return r; }
typedef float f32x2 __attribute__((ext_vector_type(2)));
template <class Epi, class Sched, bool ALIGN_EPI = false, bool SP2 = false>
__device__ __forceinline__ void gemm_phase(PG8_LAS unsigned char* lds, const Gemm g, const Sched& S, const Epi& E) {
    const int tid = threadIdx.x, wid = __builtin_amdgcn_readfirstlane(tid >> 6), lane = tid & 63, wr = wid >> 2, wc = wid & 3, fr = lane & 15, fq = lane >> 4;
    const int K = g.K, nt = K / BK;
    unsigned voffA[2], voffB[2];
#pragma unroll
    for (int i = 0; i < 2; ++i) { int R, C; stage_rc(tid * 16 + i * 8192, R, C); const int Rb = Epi::PERM ? ((R & ~31) + perm32(R & 31)) : R;
        voffA[i] = (unsigned)(R * K + C) * 2u; voffB[i] = (unsigned)(Rb * K + C) * 2u; }
    const size_t kstep = (size_t)(BK * 2);
    const size_t hstep = (size_t)HALF * K * 2;
    const size_t tstep = 2 * hstep;
    const unsigned ldsw = (unsigned)wid * 1024u;
    const int aoff = lds_byte(wr * 64 + fr, fq * 8), boff = lds_byte(wc * 32 + fr, fq * 8);
#define PG8_SA(b, h) (((b) * 2 + (h)) * HTB)
#define PG8_SB(b, h) ((4 + (b) * 2 + (h)) * HTB)
#define PG8_STAGE(bufoff, gbase, voff) do { _Pragma("unroll") for (int _i = 0; _i < 2; ++_i) \
        __builtin_amdgcn_global_load_lds((const unsigned*)((const char*)(gbase) + (voff)[_i]), (PG8_LAS unsigned*)(lds + (bufoff) + ldsw + _i * 8192), 16, 0, 0); } while (0)
#define PG8_LDA(dst, b, h) do { _Pragma("unroll") for (int m = 0; m < 4; ++m) _Pragma("unroll") for (int k = 0; k < 2; ++k) dst[m][k] = *(const PG8_LAS bf16x8*)(lds + PG8_SA(b, h) + aoff + m * 2048 + k * 1024); } while (0)
#define PG8_LDB(dst, b, h) do { _Pragma("unroll") for (int n = 0; n < 2; ++n) _Pragma("unroll") for (int k = 0; k < 2; ++k) dst[n][k] = *(const PG8_LAS bf16x8*)(lds + PG8_SB(b, h) + boff + n * 2048 + k * 1024); } while (0)
#define PG8_MMA(ai, bj, At, Bt) do { __builtin_amdgcn_s_setprio(1); _Pragma("unroll") for (int m = 0; m < 4; ++m) _Pragma("unroll") for (int n = 0; n < 2; ++n) _Pragma("unroll") for (int k = 0; k < 2; ++k) \
        acc[ai][bj][m][n] = __builtin_amdgcn_mfma_f32_16x16x32_bf16(Bt[n][k], At[m][k], acc[ai][bj][m][n], 0, 0, 0); __builtin_amdgcn_s_setprio(0); } while (0)
#define PG8_WAIT_V(n) asm volatile("s_waitcnt vmcnt(" #n ")" ::: "memory")
#define PG8_WAIT_L(n) asm volatile("s_waitcnt lgkmcnt(" #n ")" ::: "memory")
#define PG8_BAR __builtin_amdgcn_s_barrier()
#define PG8_SCHED __builtin_amdgcn_sched_barrier(0)
    Unit cur, nxt; int ui = 0;
    if (!S.next(0, cur)) return;
    f32x4 acc[2][2][4][2];
#pragma unroll
    for (int a = 0; a < 2; ++a)
#pragma unroll
        for (int b = 0; b < 2; ++b)
#pragma unroll
            for (int m = 0; m < 4; ++m)
#pragma unroll
                for (int n = 0; n < 2; ++n) acc[a][b][m][n] = (f32x4){0.f, 0.f, 0.f, 0.f};
    bf16x8 At[4][2], B0[2][2], B1[2][2];
    const char* cA = (const char*)g.A + (size_t)cur.pm * tstep; const char* cB = (const char*)g.Bt + (size_t)cur.pn * tstep;
    S.a_ready(cur);
    if constexpr (SP2) {
        PG8_STAGE(PG8_SB(0, 0), cB, voffB); PG8_STAGE(PG8_SB(0, 1), cB + hstep, voffB); PG8_STAGE(PG8_SA(0, 0), cA, voffA); PG8_STAGE(PG8_SA(0, 1), cA + hstep, voffA);
        if (wr == 1) PG8_BAR;
        PG8_WAIT_V(2); PG8_BAR;
        PG8_STAGE(PG8_SB(1, 0), cB + kstep, voffB); PG8_STAGE(PG8_SA(1, 0), cA + kstep, voffA); PG8_STAGE(PG8_SB(1, 1), cB + hstep + kstep, voffB);
        PG8_WAIT_V(6); PG8_BAR;
    } else {
        PG8_STAGE(PG8_SB(0, 0), cB, voffB); PG8_STAGE(PG8_SA(0, 0), cA, voffA); PG8_STAGE(PG8_SB(0, 1), cB + hstep, voffB); PG8_STAGE(PG8_SA(0, 1), cA + hstep, voffA);
        if (wr == 1) PG8_BAR;
        PG8_WAIT_V(4); PG8_BAR;
        PG8_STAGE(PG8_SB(1, 0), cB + kstep, voffB); PG8_STAGE(PG8_SA(1, 0), cA + kstep, voffA); PG8_STAGE(PG8_SB(1, 1), cB + hstep + kstep, voffB);
        PG8_WAIT_V(6); PG8_BAR;
    }
    for (;;) {
        const bool has_next = S.next(ui + 1, nxt);
        const char* nA = has_next ? (const char*)g.A + (size_t)nxt.pm * tstep : cA; const char* nB = has_next ? (const char*)g.Bt + (size_t)nxt.pn * tstep : cB;
        for (int t = 0; t < nt; t += 2) {
            const bool last = (t == nt - 2);
            const char* a1 = cA + (size_t)(t + 1) * kstep;
            const char* a2 = last ? nA : cA + (size_t)(t + 2) * kstep; const char* b2 = last ? nB : cB + (size_t)(t + 2) * kstep;
            const char* a3 = a2 + kstep; const char* b3 = b2 + kstep;
            if (last && has_next) S.a_ready(nxt);
            if constexpr (SP2) {
            PG8_LDB(B0, 0, 0); PG8_LDB(B1, 0, 1); PG8_SCHED; PG8_LDA(At, 0, 0); PG8_STAGE(PG8_SA(1, 1), a1 + hstep, voffA);
            PG8_WAIT_V(8); PG8_WAIT_L(0); PG8_BAR; PG8_MMA(0, 0, At, B0); PG8_MMA(0, 1, At, B1); PG8_BAR; PG8_SCHED;
            PG8_LDA(At, 0, 1); PG8_STAGE(PG8_SB(0, 0), b2, voffB); PG8_STAGE(PG8_SB(0, 1), b2 + hstep, voffB); PG8_STAGE(PG8_SA(0, 0), a2, voffA);
            PG8_WAIT_V(8); PG8_WAIT_L(0); PG8_BAR; PG8_MMA(1, 0, At, B0); PG8_MMA(1, 1, At, B1); PG8_BAR; PG8_SCHED;
            PG8_LDB(B0, 1, 0); PG8_LDB(B1, 1, 1); PG8_SCHED; PG8_LDA(At, 1, 0); PG8_STAGE(PG8_SA(0, 1), a2 + hstep, voffA);
            PG8_WAIT_V(8); PG8_WAIT_L(0); PG8_BAR; PG8_MMA(0, 0, At, B0); PG8_MMA(0, 1, At, B1); PG8_BAR; PG8_SCHED;
            PG8_LDA(At, 1, 1); PG8_STAGE(PG8_SB(1, 0), b3, voffB); PG8_STAGE(PG8_SB(1, 1), b3 + hstep, voffB); PG8_STAGE(PG8_SA(1, 0), a3, voffA);
            PG8_WAIT_V(8); PG8_WAIT_L(0); PG8_BAR; PG8_MMA(1, 0, At, B0); PG8_MMA(1, 1, At, B1); PG8_BAR; PG8_SCHED;
            } else {
            PG8_LDB(B0, 0, 0); PG8_SCHED; PG8_LDA(At, 0, 0); PG8_STAGE(PG8_SA(1, 1), a1 + hstep, voffA);
            PG8_WAIT_L(8); PG8_BAR; PG8_WAIT_L(0); PG8_MMA(0, 0, At, B0); PG8_BAR; PG8_SCHED;
            PG8_LDB(B1, 0, 1); PG8_STAGE(PG8_SB(0, 0), b2, voffB);
            PG8_BAR; PG8_WAIT_L(0); PG8_MMA(0, 1, At, B1); PG8_BAR;
            PG8_LDA(At, 0, 1); PG8_STAGE(PG8_SA(0, 0), a2, voffA);
            PG8_BAR; PG8_WAIT_L(0); PG8_MMA(1, 0, At, B0); PG8_BAR; PG8_SCHED;
            PG8_STAGE(PG8_SB(0, 1), b2 + hstep, voffB);
            PG8_WAIT_V(6); PG8_BAR; PG8_MMA(1, 1, At, B1); PG8_BAR;
            PG8_LDB(B0, 1, 0); PG8_SCHED; PG8_LDA(At, 1, 0); PG8_STAGE(PG8_SA(0, 1), a2 + hstep, voffA);
            PG8_WAIT_L(8); PG8_BAR; PG8_WAIT_L(0); PG8_MMA(0, 0, At, B0); PG8_BAR; PG8_SCHED;
            PG8_LDB(B1, 1, 1); PG8_STAGE(PG8_SB(1, 0), b3, voffB);
            PG8_BAR; PG8_WAIT_L(0); PG8_MMA(0, 1, At, B1); PG8_BAR;
            PG8_LDA(At, 1, 1); PG8_STAGE(PG8_SA(1, 0), a3, voffA);
            PG8_BAR; PG8_WAIT_L(0); PG8_MMA(1, 0, At, B0); PG8_BAR; PG8_SCHED;
            PG8_STAGE(PG8_SB(1, 1), b3 + hstep, voffB);
            PG8_WAIT_V(6); PG8_BAR; PG8_MMA(1, 1, At, B1); PG8_BAR;
            }
        }
        if constexpr (ALIGN_EPI) { if (wr == 0) PG8_BAR; }
        if constexpr (!Epi::AFTER_DRAIN) { E(acc, cur, wr, wc, fr, fq); S.done(cur); }
        if (!has_next) break;
#pragma unroll
        for (int a = 0; a < 2; ++a)
#pragma unroll
            for (int b = 0; b < 2; ++b)
#pragma unroll
                for (int m = 0; m < 4; ++m)
#pragma unroll
                    for (int n = 0; n < 2; ++n) acc[a][b][m][n] = (f32x4){0.f, 0.f, 0.f, 0.f};
        cur = nxt; cA = nA; cB = nB; ++ui;
        if constexpr (ALIGN_EPI) { if (wr == 1) PG8_BAR; }
    }
    PG8_WAIT_V(0);
    if constexpr (!ALIGN_EPI) { if (wr == 0) PG8_BAR; }
    PG8_BAR;
    if constexpr (Epi::AFTER_DRAIN) { E.fused(acc, cur, wr, wc, fr, fq, lds, wid, lane); S.done(cur); }
#undef PG8_SA
#undef PG8_SB
#undef PG8_STAGE
#undef PG8_LDA
#undef PG8_LDB
#undef PG8_MMA
#undef PG8_WAIT_V
#undef PG8_WAIT_L
#undef PG8_BAR
#undef PG8_SCHED
}
}

constexpr int D = 1024, NSEQ = 24, L = 4096, M = NSEQ * L, NIN = 4608, FF = 4096, MP = 8 * 4096;
constexpr int LDQ = 1536;
constexpr int LDG = 2048;
constexpr float EPS = 1e-6f, LOG2E = 1.4426950408889634f;
constexpr size_t MiB = 1u << 20;
constexpr size_t OFF_SS2 = 0, OFF_M0 = 393216, OFF_AP = 524288, OFF_AT = 589824, OFF_AT16 = 655360, OFF_BB = 720896, OFF_CF = 1245184;
constexpr size_t OFF_WIN = 2 * MiB, OFF_WGLU = 11 * MiB, OFF_WOUT = 13 * MiB, OFF_WUP = 15 * MiB, OFF_WDN = 23 * MiB;
constexpr size_t OFF_Y = 40 * MiB, OFF_XB = 232 * MiB, OFF_QKVU = 424 * MiB, OFF_UG = 712 * MiB, OFF_BBA = 31 * MiB, OFF_CAF = 31 * MiB + 524288, OFF_K0 = 32 * MiB, OFF_UP = 232 * MiB, WS_NEED = 1000 * MiB;
constexpr int LDS_BYTES = 147456;
#ifndef REPMASK
#define REPMASK 0
#endif
#define REPS(k) (((REPMASK >> (k)) & 1) ? 2 : 1)

typedef unsigned short bf16;
typedef short bf16x8 __attribute__((ext_vector_type(8)));
typedef short s16x4 __attribute__((ext_vector_type(4)));
typedef float f32x4 __attribute__((ext_vector_type(4)));
typedef float f32x2 __attribute__((ext_vector_type(2)));
typedef unsigned u32x4 __attribute__((ext_vector_type(4)));
typedef unsigned u32x2 __attribute__((ext_vector_type(2)));

__device__ __forceinline__ unsigned f2bf(float f) { unsigned u = __builtin_bit_cast(unsigned, f); return (u + 0x7fffu + ((u >> 16) & 1u)) >> 16; }
typedef __bf16 bf16x2_t __attribute__((ext_vector_type(2)));
__device__ __forceinline__ unsigned pk2(float lo, float hi) { const f32x2 v = {lo, hi}; const bf16x2_t b = __builtin_convertvector(v, bf16x2_t); return __builtin_bit_cast(unsigned, b); }
__device__ __forceinline__ unsigned pk2v(f32x2 v) { const bf16x2_t b = __builtin_convertvector(v, bf16x2_t); return __builtin_bit_cast(unsigned, b); }
__device__ __forceinline__ float bflo(unsigned w) { return __builtin_bit_cast(float, w << 16); }
__device__ __forceinline__ float bfhi(unsigned w) { return __builtin_bit_cast(float, w & 0xffff0000u); }
__device__ __forceinline__ float fsigmoid(float x) { return __builtin_amdgcn_rcpf(1.0f + __builtin_amdgcn_exp2f(-LOG2E * x)); }
__device__ __forceinline__ float wave_sum(float v) {
#pragma unroll
    for (int o = 1; o < 64; o <<= 1) v += __shfl_xor(v, o);
    return v;
}

struct Params {
    const float *xp, *xs, *rel_table, *ln1, *w_in, *q_gain, *k_gain, *sink, *lam_re, *lam_im, *log_dt, *b_re, *b_im, *c_re, *c_im, *d_skip, *w_glu, *b_glu, *w_out, *ln2, *w_up, *w_down;
    float* out; unsigned char* ws; int ph_lo, ph_hi;
};

using pg8::Unit; using pg8::HALF; using pg8::BM;
struct EpiProj {
    static constexpr bool PERM = true, AFTER_DRAIN = false;
    bf16* QKV; bf16* UG; bf16* GATES;
    __device__ __forceinline__ void operator()(const f32x4 (&acc)[2][2][4][2], const Unit& u, int wr, int wc, int fr, int fq) const {
        const int row0 = u.pm * BM + wr * 64 + fr, col0 = wc * 32 + 8 * fq;
        if (u.pn >= 6 && u.pn < 10) {
            const int c0 = (u.pn - 6) * 256 + col0;
#pragma unroll
            for (int ai = 0; ai < 2; ++ai)
#pragma unroll
                for (int m = 0; m < 4; ++m) { const size_t row = (size_t)(row0 + ai * HALF + m * 16);
#pragma unroll
                    for (int bj = 0; bj < 2; ++bj) { const int c = c0 + bj * HALF; const f32x4 v0 = acc[ai][bj][m][0], v1 = acc[ai][bj][m][1];
                        u32x4 w; w.x = pk2(v0[0], v0[1]); w.y = pk2(v0[2], v0[3]); w.z = pk2(v1[0], v1[1]); w.w = pk2(v1[2], v1[3]);
                        *(u32x4*)(UG + ((size_t)(c >> 4) * M + row) * 16 + (c & 15)) = w; } }
            return;
        }
        const bool gate = u.pn >= 10;
        bf16* base = gate ? GATES + (u.pn - 10) * 256 : QKV + u.pn * 256;
        const int ldc = gate ? LDG : LDQ;
#pragma unroll
        for (int ai = 0; ai < 2; ++ai)
#pragma unroll
            for (int m = 0; m < 4; ++m) { bf16* rowp = base + (size_t)(row0 + ai * HALF + m * 16) * ldc + col0;
#pragma unroll
                for (int bj = 0; bj < 2; ++bj) { f32x4 v0 = acc[ai][bj][m][0], v1 = acc[ai][bj][m][1];
                    if (gate) {
#pragma unroll
                        for (int e = 0; e < 4; ++e) { v0[e] = fsigmoid(v0[e]); v1[e] = fsigmoid(v1[e]); } }
                    u32x4 w; w.x = pk2(v0[0], v0[1]); w.y = pk2(v0[2], v0[3]); w.z = pk2(v1[0], v1[1]); w.w = pk2(v1[2], v1[3]);
                    *(u32x4*)(rowp + bj * HALF) = w; } }
    }
};
struct EpiGlu {
    static constexpr bool PERM = true, AFTER_DRAIN = false;
    const bf16* Y; const bf16* ATTG; const bf16* GS; const float* bglu; bf16* MIXED;
    __device__ __forceinline__ void operator()(const f32x4 (&acc)[2][2][4][2], const Unit& u, int wr, int wc, int fr, int fq) const {
        const int row0 = u.pm * BM + wr * 64 + fr, col0 = u.pn * BM + wc * 32 + 8 * fq;
#pragma unroll
        for (int bj = 0; bj < 2; ++bj) {
            const int col = col0 + bj * HALF;
            const f32x4 b0 = *(const f32x4*)(bglu + col), b1 = *(const f32x4*)(bglu + col + 4);
#pragma unroll
            for (int ai = 0; ai < 2; ++ai) {
                u32x4 yv[4], av[4], gv[4];
#pragma unroll
                for (int m = 0; m < 4; ++m) { const size_t row = (size_t)(row0 + ai * HALF + m * 16);
                    yv[m] = *(const u32x4*)(Y + row * D + col); av[m] = *(const u32x4*)(ATTG + row * LDQ + col); gv[m] = *(const u32x4*)(GS + row * LDG + col); }
#pragma unroll
                for (int m = 0; m < 4; ++m) { const size_t row = (size_t)(row0 + ai * HALF + m * 16);
                    const f32x4 z0 = acc[ai][bj][m][0] + b0, z1 = acc[ai][bj][m][1] + b1;
                    float r[8];
#pragma unroll
                    for (int e = 0; e < 4; ++e) { const float z = e < 2 ? z0[2 * e] : z1[2 * (e - 2)], zz = e < 2 ? z0[2 * e + 1] : z1[2 * (e - 2) + 1];
                        r[2 * e] = bflo(av[m][e]) + bflo(gv[m][e]) * bflo(yv[m][e]) * fsigmoid(z);
                        r[2 * e + 1] = bfhi(av[m][e]) + bfhi(gv[m][e]) * bfhi(yv[m][e]) * fsigmoid(zz); }
                    u32x4 w; w.x = pk2(r[0], r[1]); w.y = pk2(r[2], r[3]); w.z = pk2(r[4], r[5]); w.w = pk2(r[6], r[7]);
                    *(u32x4*)(MIXED + row * D + col) = w; } } }
    }
};
struct EpiOut {
    static constexpr bool PERM = true, AFTER_DRAIN = false;
    const float* xp; const float* xs; float* out; bf16* X1B; float* ss2;
    __device__ __forceinline__ void operator()(const f32x4 (&acc)[2][2][4][2], const Unit& u, int wr, int wc, int fr, int fq) const {
        const int row0 = u.pm * BM + wr * 64 + fr, col0 = u.pn * BM + wc * 32 + 8 * fq;
        const float* xb = (u.pm * BM < MP) ? xp : xs - (size_t)MP * D;
#pragma unroll
        for (int ai = 0; ai < 2; ++ai)
#pragma unroll
            for (int mh = 0; mh < 2; ++mh) {
                f32x4 xv[2][2][2];
#pragma unroll
                for (int mm = 0; mm < 2; ++mm)
#pragma unroll
                    for (int bj = 0; bj < 2; ++bj) { const size_t off = (size_t)(row0 + ai * HALF + (2 * mh + mm) * 16) * D + col0 + bj * HALF;
                        xv[mm][bj][0] = *(const f32x4*)(xb + off); xv[mm][bj][1] = *(const f32x4*)(xb + off + 4); }
#pragma unroll
                for (int mm = 0; mm < 2; ++mm) { const int m = 2 * mh + mm; const size_t row = (size_t)(row0 + ai * HALF + m * 16); float ssq = 0.f;
#pragma unroll
                    for (int bj = 0; bj < 2; ++bj) { const size_t off = row * D + col0 + bj * HALF;
                        const f32x4 v0 = acc[ai][bj][m][0] + xv[mm][bj][0], v1 = acc[ai][bj][m][1] + xv[mm][bj][1];
                        ssq += (v0[0] * v0[0] + v0[1] * v0[1]) + (v0[2] * v0[2] + v0[3] * v0[3]) + (v1[0] * v1[0] + v1[1] * v1[1]) + (v1[2] * v1[2] + v1[3] * v1[3]);
                        u32x4 w; w.x = pk2(v0[0], v0[1]); w.y = pk2(v0[2], v0[3]); w.z = pk2(v1[0], v1[1]); w.w = pk2(v1[2], v1[3]);
                        *(u32x4*)(X1B + off) = w; }
                    ssq += __shfl_xor(ssq, 16); ssq += __shfl_xor(ssq, 32);
                    if (fq == 0) atomicAdd(ss2 + row, ssq); } }
    }
};
struct EpiUp {
    static constexpr bool PERM = true, AFTER_DRAIN = false;
    const float* ss2; bf16* UP;
    __device__ __forceinline__ void operator()(const f32x4 (&acc)[2][2][4][2], const Unit& u, int wr, int wc, int fr, int fq) const {
        const int row0 = u.pm * BM + wr * 64 + fr, col0 = u.pn * BM + wc * 32 + 8 * fq;
#pragma unroll
        for (int ai = 0; ai < 2; ++ai)
#pragma unroll
            for (int m = 0; m < 4; ++m) { const size_t row = (size_t)(row0 + ai * HALF + m * 16);
                const float r2 = __builtin_amdgcn_rsqf(ss2[row] * (1.0f / D) + EPS);
#pragma unroll
                for (int bj = 0; bj < 2; ++bj) { f32x4 v0 = acc[ai][bj][m][0] * r2, v1 = acc[ai][bj][m][1] * r2;
#pragma unroll
                    for (int e = 0; e < 4; ++e) { const float a = fmaxf(v0[e], 0.f), b = fmaxf(v1[e], 0.f); v0[e] = a * a; v1[e] = b * b; }
                    u32x4 w; w.x = pk2(v0[0], v0[1]); w.y = pk2(v0[2], v0[3]); w.z = pk2(v1[0], v1[1]); w.w = pk2(v1[2], v1[3]);
                    *(u32x4*)(UP + row * FF + col0 + bj * HALF) = w; } }
    }
};
struct EpiDown {
    static constexpr bool PERM = true, AFTER_DRAIN = false;
    float* out; const bf16* X1B;
    __device__ __forceinline__ void operator()(const f32x4 (&acc)[2][2][4][2], const Unit& u, int wr, int wc, int fr, int fq) const {
        const int row0 = u.pm * BM + wr * 64 + fr, col0 = u.pn * BM + wc * 32 + 8 * fq;
#pragma unroll
        for (int ai = 0; ai < 2; ++ai) {
            u32x4 xv[4][2];
#pragma unroll
            for (int m = 0; m < 4; ++m)
#pragma unroll
                for (int bj = 0; bj < 2; ++bj) xv[m][bj] = *(const u32x4*)(X1B + (size_t)(row0 + ai * HALF + m * 16) * D + col0 + bj * HALF);
#pragma unroll
            for (int m = 0; m < 4; ++m)
#pragma unroll
                for (int bj = 0; bj < 2; ++bj) { float* p = out + (size_t)(row0 + ai * HALF + m * 16) * D + col0 + bj * HALF; const u32x4 x = xv[m][bj];
                    *(f32x4*)p = acc[ai][bj][m][0] + (f32x4){bflo(x.x), bfhi(x.x), bflo(x.y), bfhi(x.y)};
                    *(f32x4*)(p + 4) = acc[ai][bj][m][1] + (f32x4){bflo(x.z), bfhi(x.z), bflo(x.w), bfhi(x.w)}; } }
    }
};

__device__ __forceinline__ void transpose_item(const float* W, int K, int N, bf16* WT, const float* kscale, float* scr, int item, int lane) {
    const int nblk = N / 32, kb = item / nblk, nb = item % nblk, k0 = 64 * kb, n0 = 32 * nb;
    float tv[32];
#pragma unroll
    for (int i = 0; i < 32; ++i) tv[i] = W[(size_t)(k0 + 2 * i + (lane >> 5)) * N + n0 + (lane & 31)];
#pragma unroll
    for (int i = 0; i < 32; ++i) { const int kk = 2 * i + (lane >> 5); float v = tv[i]; if (kscale) v *= kscale[k0 + kk]; scr[kk * 33 + (lane & 31)] = v; }
    asm volatile("s_waitcnt lgkmcnt(0)" ::: "memory");
    const int c = lane & 7;
#pragma unroll
    for (int j = 0; j < 4; ++j) { const int n = (lane >> 3) + 8 * j; const float* s = scr + (8 * c) * 33 + n;
        u32x4 o; o.x = pk2(s[0 * 33], s[1 * 33]); o.y = pk2(s[2 * 33], s[3 * 33]); o.z = pk2(s[4 * 33], s[5 * 33]); o.w = pk2(s[6 * 33], s[7 * 33]);
        *(u32x4*)(WT + (size_t)(n0 + n) * K + k0 + 8 * c) = o; }
    asm volatile("s_waitcnt lgkmcnt(0)" ::: "memory");
}
__device__ __forceinline__ void sincos_d(double x, double& s, double& c) {
    const double k = __builtin_rint(x * 0.63661977236758134308), r = (x - k * 1.5707963267948966) - k * 6.123233995736766e-17, r2 = r * r;
    double sp = 1.0, cp = 1.0;
#pragma unroll
    for (int i = 10; i >= 1; --i) { sp = 1.0 - sp * r2 / (double)((2 * i) * (2 * i + 1)); cp = 1.0 - cp * r2 / (double)((2 * i - 1) * (2 * i)); }
    sp *= r;
    const int q = ((int)k) & 3;
    s = (q == 0) ? sp : (q == 1) ? cp : (q == 2) ? -sp : -cp;
    c = (q == 0) ? cp : (q == 1) ? -sp : (q == 2) ? -cp : sp;
}
__device__ __forceinline__ void ssm_disc(const Params& P, int dg, int p, double& are, double& aim, double& cre, double& cim) {
    const double dt = exp((double)P.log_dt[dg]);
    const double lr = (double)P.lam_re[dg * 64 + p], li = (double)P.lam_im[dg * 64 + p];
    const double mag = exp(lr * dt); double sn, cs; sincos_d(li * dt, sn, cs);
    are = mag * cs; aim = mag * sn;
    const double den = lr * lr + li * li, nr = are - 1.0, ni = aim;
    cre = (nr * lr + ni * li) / den; cim = (ni * lr - nr * li) / den;
}
__device__ __forceinline__ void ssm_prep(const Params& P, int dg, int lane, float* scr) {
    unsigned char* ws = P.ws;
    const int p = lane;
    double are, aim, cre, cim; ssm_disc(P, dg, p, are, aim, cre, cim);
    ((f32x2*)(ws + OFF_AP))[dg * 64 + p] = (f32x2){(float)are, (float)aim};
    double pr = are, pi = aim;
#pragma unroll 1
    for (int i = 0; i < 10; ++i) { const double nr_ = pr * pr - pi * pi, ni_ = 2.0 * pr * pi; pr = nr_; pi = ni_;
        if (i == 5) ((f32x2*)(ws + OFF_AT))[dg * 64 + p] = (f32x2){(float)pr, (float)pi}; }
    ((f32x2*)(ws + OFF_AT16))[dg * 64 + p] = (f32x2){(float)pr, (float)pi};
    bf16* BB = (bf16*)(ws + OFF_BB); bf16* BBA = (bf16*)(ws + OFF_BBA);
#pragma unroll 4
    for (int c = 0; c < 16; ++c) { const double br = (double)P.b_re[(size_t)(dg * 64 + p) * 16 + c], bi = (double)P.b_im[(size_t)(dg * 64 + p) * 16 + c];
        const double bbr = cre * br - cim * bi, bbi = cre * bi + cim * br;
        BB[((size_t)(dg * 2 + 0) * 64 + p) * 16 + c] = (bf16)f2bf((float)bbr);
        BB[((size_t)(dg * 2 + 1) * 64 + p) * 16 + c] = (bf16)f2bf((float)bbi);
        BBA[((size_t)(dg * 2 + 0) * 64 + p) * 16 + c] = (bf16)f2bf((float)(are * bbr - aim * bbi));
        BBA[((size_t)(dg * 2 + 1) * 64 + p) * 16 + c] = (bf16)f2bf((float)(are * bbi + aim * bbr));
        scr[(p * 16 + c) * 2] = (float)bbr; scr[(p * 16 + c) * 2 + 1] = (float)bbi; }
    scr[2048 + 2 * p] = (float)are; scr[2048 + 2 * p + 1] = (float)aim;
    asm volatile("s_waitcnt lgkmcnt(0)" ::: "memory");
    bf16* CF = (bf16*)(ws + OFF_CF); bf16* CAF = (bf16*)(ws + OFF_CAF);
    for (int e = lane; e < 2048; e += 64) { const int jj = e & 7, fq = (e >> 3) & 3, c = (e >> 5) & 15, s = e >> 9;
        const int pp = 16 * (2 * (s & 1) + (jj >> 2)) + 4 * fq + (jj & 3);
        const float v = (s < 2) ? P.c_re[(size_t)(dg * 16 + c) * 64 + pp] : -P.c_im[(size_t)(dg * 16 + c) * 64 + pp];
        CF[(size_t)dg * 2048 + e] = (bf16)f2bf(v);
        const float cr = P.c_re[(size_t)(dg * 16 + c) * 64 + pp], ci = P.c_im[(size_t)(dg * 16 + c) * 64 + pp], ar_ = scr[2048 + 2 * pp], ai_ = scr[2048 + 2 * pp + 1];
        CAF[(size_t)dg * 2048 + e] = (bf16)f2bf((s < 2) ? cr * ar_ - ci * ai_ : -(cr * ai_ + ci * ar_)); }
    bf16* K0 = (bf16*)(ws + OFF_K0);
    { const int co = lane >> 2, cin0 = (lane & 3) * 4; float acc[4] = {0.f, 0.f, 0.f, 0.f};
#pragma unroll 8
        for (int pp = 0; pp < 64; ++pp) { const float cr = P.c_re[(size_t)(dg * 16 + co) * 64 + pp], ci = P.c_im[(size_t)(dg * 16 + co) * 64 + pp];
#pragma unroll
            for (int i = 0; i < 4; ++i) acc[i] += cr * scr[(pp * 16 + cin0 + i) * 2] - ci * scr[(pp * 16 + cin0 + i) * 2 + 1]; }
        *(u32x2*)(K0 + (size_t)dg * 256 + lane * 4) = (u32x2){pk2(acc[0], acc[1]), pk2(acc[2], acc[3])}; }
    asm volatile("s_waitcnt lgkmcnt(0)" ::: "memory");
}
__device__ __forceinline__ void p0_prologue(const Params& P, unsigned char* lds, int tid, int wave, int lane) {
    unsigned char* ws = P.ws;
    float* scr = (float*)(lds + wave * 16384);
    const int gw = blockIdx.x * 8 + wave, NGW = gridDim.x * 8;
    constexpr int I_IN = 16 * (NIN / 32), I_G = 16 * 32, I_UP = 16 * (FF / 32), I_DN = (FF / 64) * 32;
    constexpr int NITEMS = I_IN + 2 * I_G + I_UP + I_DN;
    for (int it = gw; it < NITEMS; it += NGW) {
        int r = it;
        if (r < I_IN) { transpose_item(P.w_in, D, NIN, (bf16*)(ws + OFF_WIN), nullptr, scr, r, lane); continue; } r -= I_IN;
        if (r < I_G) { transpose_item(P.w_glu, D, D, (bf16*)(ws + OFF_WGLU), nullptr, scr, r, lane); continue; } r -= I_G;
        if (r < I_G) { transpose_item(P.w_out, D, D, (bf16*)(ws + OFF_WOUT), nullptr, scr, r, lane); continue; } r -= I_G;
        if (r < I_UP) { transpose_item(P.w_up, D, FF, (bf16*)(ws + OFF_WUP), P.ln2, scr, r, lane); continue; } r -= I_UP;
        transpose_item(P.w_down, FF, D, (bf16*)(ws + OFF_WDN), nullptr, scr, r, lane);
    }
    if (wave == 7) for (int dg = blockIdx.x; dg < 128; dg += gridDim.x) ssm_prep(P, dg, lane, scr);
    if (blockIdx.x == gridDim.x - 1 && wave == 6) {
        float gq = fabsf(P.q_gain[lane]), gk = fabsf(P.k_gain[lane]);
#pragma unroll
        for (int o = 1; o < 64; o <<= 1) { gq = fmaxf(gq, __shfl_xor(gq, o)); gk = fmaxf(gk, __shfl_xor(gk, o)); }
        if (lane < 16) { float bm = 0.f; for (int b = 0; b < 32; ++b) bm = fmaxf(bm, fabsf(P.rel_table[b * 16 + lane]));
            ((float*)(ws + OFF_M0))[lane] = fmaxf((8.0f * gq * gk * 1.0001f + bm) * LOG2E, P.sink[lane] * LOG2E); }
    }
    float* ss2 = (float*)(ws + OFF_SS2);
    for (int i = blockIdx.x * 512 + tid; i < M; i += gridDim.x * 512) ss2[i] = 0.f;
    f32x4 gl[4];
#pragma unroll
    for (int j = 0; j < 4; ++j) gl[j] = ((const f32x4*)P.ln1)[lane + 64 * j];
    bf16* XB = (bf16*)(ws + OFF_XB);
    f32x4 v[4], vn[4], vnn[4];
    auto xrp = [&](int m) { return (const f32x4*)((m < MP) ? P.xp + (size_t)m * D : P.xs + (size_t)(m - MP) * D) + lane; };
    if (gw < M) { const f32x4* xr = xrp(gw);
#pragma unroll
        for (int j = 0; j < 4; ++j) v[j] = xr[64 * j]; }
    if (gw + NGW < M) { const f32x4* xr = xrp(gw + NGW);
#pragma unroll
        for (int j = 0; j < 4; ++j) vn[j] = xr[64 * j]; }
    for (int m = gw; m < M; m += NGW) {
        const int mnn = m + 2 * NGW;
        if (mnn < M) { const f32x4* xr = xrp(mnn);
#pragma unroll
            for (int j = 0; j < 4; ++j) vnn[j] = xr[64 * j]; }
        float s = 0.f;
#pragma unroll
        for (int j = 0; j < 4; ++j) s += (v[j].x * v[j].x + v[j].y * v[j].y) + (v[j].z * v[j].z + v[j].w * v[j].w);
        const float rstd = 1.0f / sqrtf(wave_sum(s) * (1.f / D) + EPS);
        u32x2* o8 = (u32x2*)(XB + (size_t)m * D) + lane;
#pragma unroll
        for (int j = 0; j < 4; ++j) { const f32x4 t = v[j] * rstd * gl[j]; o8[64 * j] = (u32x2){pk2(t.x, t.y), pk2(t.z, t.w)}; }
#pragma unroll
        for (int j = 0; j < 4; ++j) { v[j] = vn[j]; vn[j] = vnn[j]; }
    }
}

constexpr int KST = 72;
constexpr int AT_K = 0, AT_V = 2 * 64 * KST * 2, AT_TB = 4 * 64 * KST * 2, AT_Q = AT_TB + 8192;
__device__ __forceinline__ void attn_phase(const Params& P, unsigned char* lds, int tid_in, int w, int lane_in) {
    bf16* QKVU = (bf16*)(P.ws + OFF_QKVU);
    const bf16* GATES = (const bf16*)P.out;
    const int g = w >> 1, qh = w & 1;
    float* tb = (float*)(lds + AT_TB);
    int tb_kh = -1;
    for (int item = blockIdx.x; item < NSEQ * 32 * 4; item += gridDim.x) {
        int lane = lane_in; asm volatile("" : "+v"(lane));
        const int tid = w * 64 + lane, fr = lane & 15, fq = lane >> 4;
        const int kh = item & 3, n = (item >> 2) & 31, seq = item >> 7, h = kh * 4 + g;
        const size_t m0 = (size_t)seq * L + n * 128;
        __syncthreads();
        if (kh != tb_kh) {
            tb_kh = kh;
            for (int e = tid; e < 4 * 512; e += 512) { const int gg = e >> 9, idx = e & 511, rel = idx - 255; float v = -1e30f;
                if (rel >= -128 && rel <= 128) { const int na = rel < 0 ? -rel : rel;
                    int b = na < 8 ? na : 8 + (na >= 12) + (na >= 16) + (na >= 23) + (na >= 32) + (na >= 46) + (na >= 64) + (na >= 91);
                    b += rel > 0 ? 16 : 0; v = P.rel_table[b * 16 + kh * 4 + gg] * LOG2E - ((const float*)(P.ws + OFF_M0))[kh * 4 + gg]; }
                tb[e] = v; }
        }
        const int c_lo = (n == 0) ? 2 : 0, c_hi = (n == 31) ? 4 : 6;
        u32x4 kreg, vreg;
        auto gload = [&](int c) {
            const size_t mk = m0 - 128 + 64 * c;
            kreg = *(const u32x4*)(QKVU + (mk + (tid >> 3)) * LDQ + 1024 + kh * 64 + 8 * (tid & 7));
            vreg = *(const u32x4*)(QKVU + (mk + lane) * LDQ + 1280 + kh * 64 + 8 * w);
        };
        bf16x8* Qs = (bf16x8*)(lds + AT_Q + w * 8192) + lane;
#pragma unroll
        for (int qg = 0; qg < 4; ++qg)
#pragma unroll
            for (int ks = 0; ks < 2; ++ks)
                __builtin_amdgcn_global_load_lds((const unsigned*)(QKVU + (m0 + 64 * qh + 16 * qg + fr) * LDQ + h * 64 + 32 * ks + 8 * fq),
                                                 (PG8_LAS unsigned*)((PG8_LAS unsigned char*)lds + AT_Q + w * 8192 + (qg * 2 + ks) * 1024), 16, 0, 0);
        gload(c_lo);
        asm volatile("s_waitcnt vmcnt(0)" ::: "memory");
        {
            float gq[2][8];
#pragma unroll
            for (int ks = 0; ks < 2; ++ks)
#pragma unroll
                for (int j = 0; j < 8; ++j) gq[ks][j] = P.q_gain[32 * ks + 8 * fq + j] * (0.125f * LOG2E);
#pragma unroll 1
            for (int qg = 0; qg < 4; ++qg) {
                const u32x4 r0 = __builtin_bit_cast(u32x4, Qs[(qg * 2 + 0) * 64]), r1 = __builtin_bit_cast(u32x4, Qs[(qg * 2 + 1) * 64]);
                float f[2][8]; float ss = 0.f;
#pragma unroll
                for (int e = 0; e < 4; ++e) { f[0][2 * e] = bflo(r0[e]); f[0][2 * e + 1] = bfhi(r0[e]); f[1][2 * e] = bflo(r1[e]); f[1][2 * e + 1] = bfhi(r1[e]); }
#pragma unroll
                for (int j = 0; j < 8; ++j) ss += f[0][j] * f[0][j] + f[1][j] * f[1][j];
                ss += __shfl_xor(ss, 16); ss += __shfl_xor(ss, 32);
                const float rn = 1.0f / sqrtf(ss * (1.f / 64) + EPS);
#pragma unroll
                for (int ks = 0; ks < 2; ++ks) { u32x4 o;
#pragma unroll
                    for (int e = 0; e < 4; ++e) o[e] = pk2(f[ks][2 * e] * rn * gq[ks][2 * e], f[ks][2 * e + 1] * rn * gq[ks][2 * e + 1]);
                    Qs[(qg * 2 + ks) * 64] = __builtin_bit_cast(bf16x8, o); }
            }
        }
        const float sinkp = __builtin_amdgcn_exp2f(P.sink[h] * LOG2E - ((const float*)(P.ws + OFF_M0))[h]);
        f32x4 O[4][4]; float lrow[4];
#pragma unroll
        for (int qg = 0; qg < 4; ++qg) { lrow[qg] = (fq == 0) ? sinkp : 0.f;
#pragma unroll
            for (int dt = 0; dt < 4; ++dt) O[qg][dt] = (f32x4){0.f, 0.f, 0.f, 0.f}; }
        auto lstore = [&](int buf) {
            float f[8]; float ss = 0.f; float gk[8];
#pragma unroll
            for (int j = 0; j < 8; ++j) gk[j] = P.k_gain[8 * (tid & 7) + j];
#pragma unroll
            for (int e = 0; e < 4; ++e) { f[2 * e] = bflo(kreg[e]); f[2 * e + 1] = bfhi(kreg[e]); }
#pragma unroll
            for (int j = 0; j < 8; ++j) ss += f[j] * f[j];
            ss += __shfl_xor(ss, 1); ss += __shfl_xor(ss, 2); ss += __shfl_xor(ss, 4);
            const float rn = 1.0f / sqrtf(ss * (1.f / 64) + EPS);
            u32x4 o;
#pragma unroll
            for (int e = 0; e < 4; ++e) o[e] = pk2(f[2 * e] * rn * gk[2 * e], f[2 * e + 1] * rn * gk[2 * e + 1]);
            *(u32x4*)(lds + AT_K + buf * (64 * KST * 2) + ((tid >> 3) * KST + 8 * (tid & 7)) * 2) = o;
            bf16* vt = (bf16*)(lds + AT_V + buf * (64 * KST * 2));
#pragma unroll
            for (int e = 0; e < 4; ++e) { vt[(8 * w + 2 * e) * KST + lane] = (bf16)(vreg[e] & 0xffffu); vt[(8 * w + 2 * e + 1) * KST + lane] = (bf16)(vreg[e] >> 16); }
        };
        lstore(0);
        __syncthreads();
        for (int c = c_lo; c < c_hi; ++c) {
            const int buf = (c - c_lo) & 1;
            if (c + 1 < c_hi) gload(c + 1);
            const bool skip = (qh == 0 && c == 5) || (qh == 1 && c == 0);
            if (!skip) {
                const unsigned char* kb = lds + AT_K + buf * (64 * KST * 2);
                const unsigned char* vb = lds + AT_V + buf * (64 * KST * 2);
                bf16x8 Kf[4][2];
#pragma unroll
                for (int t = 0; t < 4; ++t)
#pragma unroll
                    for (int ks = 0; ks < 2; ++ks) Kf[t][ks] = *(const bf16x8*)(kb + ((16 * t + fr) * KST + 32 * ks + 8 * fq) * 2);
#pragma unroll
                for (int qg = 0; qg < 4; ++qg) {
                    f32x4 S[4];
                    __builtin_amdgcn_sched_barrier(0);
                    const bf16x8 Qf0 = Qs[(qg * 2 + 0) * 64], Qf1 = Qs[(qg * 2 + 1) * 64];
#pragma unroll
                    for (int t = 0; t < 4; ++t) { S[t] = (f32x4){0.f, 0.f, 0.f, 0.f};
#pragma unroll
                        for (int ks = 0; ks < 2; ++ks) S[t] = __builtin_amdgcn_mfma_f32_16x16x32_bf16(Kf[t][ks], ks == 0 ? Qf0 : Qf1, S[t], 0, 0, 0); }
                    const int q = 64 * qh + 16 * qg + fr;
                    const float* tbp = tb + g * 512 + (64 * c - 128 + 4 * fq - q + 255);
                    float rs = 0.f;
#pragma unroll
                    for (int t = 0; t < 4; ++t)
#pragma unroll
                        for (int j = 0; j < 4; ++j) { S[t][j] = __builtin_amdgcn_exp2f(S[t][j] + tbp[16 * t + j]); rs += S[t][j]; }
                    lrow[qg] += rs;
                    bf16x8 Pf[2];
#pragma unroll
                    for (int s = 0; s < 2; ++s) { u32x4 o; o.x = pk2(S[2 * s][0], S[2 * s][1]); o.y = pk2(S[2 * s][2], S[2 * s][3]); o.z = pk2(S[2 * s + 1][0], S[2 * s + 1][1]); o.w = pk2(S[2 * s + 1][2], S[2 * s + 1][3]);
                        Pf[s] = __builtin_bit_cast(bf16x8, o); }
                    __builtin_amdgcn_sched_barrier(0);
#pragma unroll
                    for (int dt = 0; dt < 4; ++dt)
#pragma unroll
                        for (int s = 0; s < 2; ++s) { const s16x4 lo = *(const s16x4*)(vb + ((16 * dt + fr) * KST + 32 * s + 4 * fq) * 2), hi = *(const s16x4*)(vb + ((16 * dt + fr) * KST + 32 * s + 16 + 4 * fq) * 2);
                            const bf16x8 Vf = (bf16x8){lo[0], lo[1], lo[2], lo[3], hi[0], hi[1], hi[2], hi[3]};
                            O[qg][dt] = __builtin_amdgcn_mfma_f32_16x16x32_bf16(Vf, Pf[s], O[qg][dt], 0, 0, 0); }
                }
            }
            if (c + 1 < c_hi) lstore(buf ^ 1);
            __syncthreads();
        }
        u32x2 gv[4][4];
#pragma unroll
        for (int qg = 0; qg < 4; ++qg)
#pragma unroll
            for (int dt = 0; dt < 4; ++dt) gv[qg][dt] = *(const u32x2*)(GATES + (m0 + 64 * qh + 16 * qg + fr) * LDG + h * 64 + 16 * dt + 4 * fq);
#pragma unroll
        for (int qg = 0; qg < 4; ++qg) {
            float lt = lrow[qg]; lt += __shfl_xor(lt, 16); lt += __shfl_xor(lt, 32);
            const float inv = 1.0f / lt;
            const size_t row = m0 + 64 * qh + 16 * qg + fr;
#pragma unroll
            for (int dt = 0; dt < 4; ++dt) { const int col = h * 64 + 16 * dt + 4 * fq;
                const f32x4 o = O[qg][dt] * inv;
                *(u32x2*)(QKVU + row * LDQ + col) = (u32x2){pk2(o[0] * bflo(gv[qg][dt].x), o[1] * bfhi(gv[qg][dt].x)), pk2(o[2] * bflo(gv[qg][dt].y), o[3] * bfhi(gv[qg][dt].y))}; }
        }
    }
}

constexpr int SS_TOT = 131072;
__device__ __forceinline__ float gelu_tanh(float x) {
    const float t = x + 0.044715f * x * x * x;
    return x * __builtin_amdgcn_rcpf(1.0f + __builtin_amdgcn_exp2f(-2.0f * 0.7978845608028654f * LOG2E * t));
}
__device__ __forceinline__ f32x2 gelu_tanh2(f32x2 x) {
    const f32x2 x2 = x * x, t = x * (x2 * 0.044715f + 1.0f), a = t * (-2.0f * 0.7978845608028654f * LOG2E);
    f32x2 e; e.x = __builtin_amdgcn_exp2f(a.x); e.y = __builtin_amdgcn_exp2f(a.y);
    const f32x2 d = e + 1.0f; f32x2 r; r.x = __builtin_amdgcn_rcpf(d.x); r.y = __builtin_amdgcn_rcpf(d.y);
    return x * r;
}
__device__ __forceinline__ f32x2 cmul(f32x2 a, f32x2 b);
template <int DIR>
__device__ __forceinline__ void ssm_emit(f32x4 y, u32x2 ulo, unsigned long long ybv, f32x4 dsk, u32x2* yp) {
    if (DIR == 1) { *yp = (u32x2){pk2(y[0], y[1]), pk2(y[2], y[3])}; }
    else {
        const unsigned yl = (unsigned)ybv, yh = (unsigned)(ybv >> 32);
        const f32x2 ya = (f32x2){y[0], y[1]} + (f32x2){bflo(yl), bfhi(yl)} + (f32x2){dsk[0], dsk[1]} * (f32x2){bflo(ulo.x), bfhi(ulo.x)};
        const f32x2 yb = (f32x2){y[2], y[3]} + (f32x2){bflo(yh), bfhi(yh)} + (f32x2){dsk[2], dsk[3]} * (f32x2){bflo(ulo.y), bfhi(ulo.y)};
        *yp = (u32x2){pk2v(gelu_tanh2(ya)), pk2v(gelu_tanh2(yb))};
    }
}
template <int DIR, bool OUT>
__device__ __forceinline__ void ssm_pair(const bf16x8 (&Bf2)[4][2], const bf16x8 (&Cf)[4], const bf16x8 (&CAf)[4], s16x4 K0f, const f32x2 (&a2r)[4][2], const f32x2 (&a2i)[4][2],
                                         f32x2 (&hr)[4][2], f32x2 (&hi)[4][2], bf16x8 (&hB)[4], u32x2 u1, u32x2 u2, unsigned long long yb1, unsigned long long yb2, f32x4 dsk, u32x2* yp1, u32x2* yp2) {
    const f32x4 z = (f32x4){0.f, 0.f, 0.f, 0.f};
    f32x4 y1 = z;
    if (OUT) {
        const u32x2 k0_ = __builtin_bit_cast(u32x2, K0f);
        y1 = __builtin_amdgcn_mfma_f32_16x16x32_bf16(__builtin_bit_cast(bf16x8, ((u32x4){k0_.x, k0_.y, 0u, 0u})), __builtin_bit_cast(bf16x8, ((u32x4){u1.x, u1.y, 0u, 0u})), z, 0, 0, 0);
#pragma unroll
        for (int s = 0; s < 4; ++s) y1 = __builtin_amdgcn_mfma_f32_16x16x32_bf16(CAf[s], hB[s], y1, 0, 0, 0); }
    const bf16x8 uB = __builtin_bit_cast(bf16x8, ((u32x4){u1.x, u1.y, u2.x, u2.y}));
#pragma unroll
    for (int pt = 0; pt < 4; ++pt) {
        const f32x4 br = __builtin_amdgcn_mfma_f32_16x16x32_bf16(Bf2[pt][0], uB, z, 0, 0, 0);
        const f32x4 bi = __builtin_amdgcn_mfma_f32_16x16x32_bf16(Bf2[pt][1], uB, z, 0, 0, 0);
#pragma unroll
        for (int jj = 0; jj < 2; ++jj) { const f32x2 brp = (f32x2){br[2 * jj], br[2 * jj + 1]}, bip = (f32x2){bi[2 * jj], bi[2 * jj + 1]}, r0 = hr[pt][jj], i0 = hi[pt][jj];
            hr[pt][jj] = a2r[pt][jj] * r0 - a2i[pt][jj] * i0 + brp;
            hi[pt][jj] = a2r[pt][jj] * i0 + a2i[pt][jj] * r0 + bip; }
    }
    if (!OUT) return;
    ssm_emit<DIR>(y1, u1, yb1, dsk, yp1);
    f32x4 y2 = z;
#pragma unroll
    for (int s = 0; s < 4; ++s) { const int p0 = 2 * (s & 1); u32x4 o;
        if (s < 2) { o.x = pk2v(hr[p0][0]); o.y = pk2v(hr[p0][1]); o.z = pk2v(hr[p0 + 1][0]); o.w = pk2v(hr[p0 + 1][1]); }
        else       { o.x = pk2v(hi[p0][0]); o.y = pk2v(hi[p0][1]); o.z = pk2v(hi[p0 + 1][0]); o.w = pk2v(hi[p0 + 1][1]); }
        hB[s] = __builtin_bit_cast(bf16x8, o);
        y2 = __builtin_amdgcn_mfma_f32_16x16x32_bf16(Cf[s], hB[s], y2, 0, 0, 0); }
    ssm_emit<DIR>(y2, u2, yb2, dsk, yp2);
}
template <int DIR, bool OUT>
__device__ __forceinline__ void ssm_pass2(const Params& P, const bf16* UG, bf16* YP, bf16* Y, f32x2* EP, int seq, int g, int q, int fr_in, int fq_in) {
    int fr = fr_in, fq = fq_in; asm volatile("" : "+v"(fr), "+v"(fq));
    const int dg = DIR * 64 + g;
    const bf16* BB = (const bf16*)(P.ws + OFF_BB); const bf16* BBA = (const bf16*)(P.ws + OFF_BBA); const f32x2* AP = (const f32x2*)(P.ws + OFF_AP);
    const bf16* CF = (const bf16*)(P.ws + OFF_CF); const bf16* CAF = (const bf16*)(P.ws + OFF_CAF); const bf16* K0 = (const bf16*)(P.ws + OFF_K0);
    bf16x8 Bf2[4][2], Cf[4], CAf[4], hB[4]; f32x2 a2r[4][2], a2i[4][2], hr[4][2], hi[4][2];
#pragma unroll
    for (int pt = 0; pt < 4; ++pt) {
#pragma unroll
        for (int ri = 0; ri < 2; ++ri) { const size_t o_ = ((size_t)(dg * 2 + ri) * 64 + 16 * pt + fr) * 16 + 4 * fq; const u32x2 lo = *(const u32x2*)(BBA + o_), hi2 = *(const u32x2*)(BB + o_);
            Bf2[pt][ri] = __builtin_bit_cast(bf16x8, ((u32x4){lo.x, lo.y, hi2.x, hi2.y})); }
#pragma unroll
        for (int jj = 0; jj < 2; ++jj) { const f32x2 a0 = AP[dg * 64 + 16 * pt + 4 * fq + 2 * jj], a1 = AP[dg * 64 + 16 * pt + 4 * fq + 2 * jj + 1], s0 = cmul(a0, a0), s1 = cmul(a1, a1);
            a2r[pt][jj] = (f32x2){s0.x, s1.x}; a2i[pt][jj] = (f32x2){s0.y, s1.y};
            if (OUT) { const f32x2 e0 = EP[DIR * 1024 + (16 * pt + 4 * fq + 2 * jj) * 16 + fr], e1 = EP[DIR * 1024 + (16 * pt + 4 * fq + 2 * jj + 1) * 16 + fr]; hr[pt][jj] = (f32x2){e0.x, e1.x}; hi[pt][jj] = (f32x2){e0.y, e1.y}; }
            else { hr[pt][jj] = (f32x2){0.f, 0.f}; hi[pt][jj] = (f32x2){0.f, 0.f}; } }
    }
#pragma unroll
    for (int s = 0; s < 4; ++s) { if (!OUT) { Cf[s] = (bf16x8){0, 0, 0, 0, 0, 0, 0, 0}; CAf[s] = Cf[s]; hB[s] = Cf[s]; continue; }
        Cf[s] = *(const bf16x8*)(CF + (size_t)dg * 2048 + ((s * 16 + fr) * 4 + fq) * 8); CAf[s] = *(const bf16x8*)(CAF + (size_t)dg * 2048 + ((s * 16 + fr) * 4 + fq) * 8);
        const int p0 = 2 * (s & 1); u32x4 o;
        if (s < 2) { o.x = pk2v(hr[p0][0]); o.y = pk2v(hr[p0][1]); o.z = pk2v(hr[p0 + 1][0]); o.w = pk2v(hr[p0 + 1][1]); }
        else       { o.x = pk2v(hi[p0][0]); o.y = pk2v(hi[p0][1]); o.z = pk2v(hi[p0 + 1][0]); o.w = pk2v(hi[p0 + 1][1]); }
        hB[s] = __builtin_bit_cast(bf16x8, o); }
    s16x4 K0f = (s16x4){0, 0, 0, 0}; if (OUT) K0f = *(const s16x4*)(K0 + (size_t)dg * 256 + fr * 16 + 4 * fq);
    f32x4 dsk = (f32x4){0.f, 0.f, 0.f, 0.f};
    if (OUT && DIR == 0) dsk = *(const f32x4*)(P.d_skip + 16 * g + 4 * fq);
    const size_t rowu = (size_t)seq * L + 64 * 16 * q;
    const bf16* Ub = UG + ((size_t)g * M + rowu) * 16;
    bf16* Pb = YP + ((size_t)g * M + rowu) * 16;
    bf16* Yb = Y + rowu * D + 16 * g;
    const unsigned og = (unsigned)(64 * fr * 16 + 4 * fq) / 4, oy = (unsigned)(64 * fr * D + 4 * fq) / 4;
    constexpr bool NEEDY = OUT && DIR == 0;
    u32x2 bU[2][4]; unsigned long long bY[2][4];
#define TAU(st) (DIR == 0 ? (st) : 63 - (st))
#define SSM_LOAD(B, blk) do { _Pragma("unroll") for (int k_ = 0; k_ < 4; ++k_) { const int tau_ = TAU((blk) * 4 + k_); \
        bU[B][k_] = ((const u32x2*)(Ub + (size_t)tau_ * 16))[og]; \
        if (NEEDY) bY[B][k_] = __hip_atomic_load((const unsigned long long*)(Pb + (size_t)tau_ * 16) + og, __ATOMIC_RELAXED, __HIP_MEMORY_SCOPE_AGENT); } } while (0)
#define YPTR(st) (DIR == 1 ? (u32x2*)(Pb + (size_t)TAU(st) * 16) + og : (u32x2*)(Yb + (size_t)TAU(st) * D) + oy)
#define SSM_PAIRS(B, blk) do { _Pragma("unroll") for (int k_ = 0; k_ < 4; k_ += 2) { const int st_ = (blk) * 4 + k_; __builtin_amdgcn_sched_barrier(0); \
        ssm_pair<DIR, OUT>(Bf2, Cf, CAf, K0f, a2r, a2i, hr, hi, hB, bU[B][k_], bU[B][k_ + 1], NEEDY ? bY[B][k_] : 0ull, NEEDY ? bY[B][k_ + 1] : 0ull, dsk, YPTR(st_), YPTR(st_ + 1)); } } while (0)
    SSM_LOAD(0, 0);
#pragma unroll 1
    for (int b = 0; b < 16; b += 2) {
        SSM_LOAD(1, b + 1);
        __builtin_amdgcn_sched_barrier(0);
        SSM_PAIRS(0, b);
        if (b + 2 < 16) SSM_LOAD(0, b + 2);
        __builtin_amdgcn_sched_barrier(0);
        SSM_PAIRS(1, b + 1);
    }
#undef SSM_LOAD
#undef SSM_PAIRS
#undef YPTR
#undef TAU
    if (!OUT) {
#pragma unroll
        for (int pt = 0; pt < 4; ++pt)
#pragma unroll
            for (int jj = 0; jj < 2; ++jj) { EP[DIR * 1024 + (16 * pt + 4 * fq + 2 * jj) * 16 + fr] = (f32x2){hr[pt][jj].x, hi[pt][jj].x}; EP[DIR * 1024 + (16 * pt + 4 * fq + 2 * jj + 1) * 16 + fr] = (f32x2){hr[pt][jj].y, hi[pt][jj].y}; }
    }
    asm volatile("s_waitcnt vmcnt(0) lgkmcnt(0)" ::: "memory");
}
__device__ __forceinline__ f32x2 cmul(f32x2 a, f32x2 b) { return (f32x2){a.x * b.x - a.y * b.y, a.x * b.y + a.y * b.x}; }
template <int DIR>
__device__ __forceinline__ f32x2 ssm_carry1(f32x2* EPd, f32x2 aT, int lane) {
    f32x2 e[16];
#pragma unroll
    for (int kk = 0; kk < 16; ++kk) e[kk] = EPd[lane * 16 + kk];
    f32x2 acc = (f32x2){0.f, 0.f};
#pragma unroll
    for (int i = 0; i < 16; ++i) { const int kk = DIR == 0 ? i : 15 - i; EPd[lane * 16 + kk] = acc; acc = cmul(aT, acc) + e[kk]; }
    return acc;
}
template <int DIR>
__device__ __forceinline__ void ssm_carry2(f32x2* EPd, f32x2 aT, f32x2 Hq, int lane) {
    f32x2 e[16];
#pragma unroll
    for (int kk = 0; kk < 16; ++kk) e[kk] = EPd[lane * 16 + kk];
    f32x2 pw = Hq;
#pragma unroll
    for (int i = 0; i < 16; ++i) { const int kk = DIR == 0 ? i : 15 - i; EPd[lane * 16 + kk] = e[kk] + pw; pw = cmul(aT, pw); }
}
__device__ __forceinline__ void ssm_phase(const Params& P, unsigned char* lds, int tid, int w, int lane) {
    const bf16* UG = (const bf16*)(P.ws + OFF_UG);
    bf16* Y = (bf16*)(P.ws + OFF_Y); bf16* YP = (bf16*)(P.ws + OFF_XB);
    const int fr = lane & 15, fq = lane >> 4, q = w & 3, ps = w >> 2;
    f32x2* EP = (f32x2*)(lds + w * 16384);
    f32x2* TOT = (f32x2*)(lds + SS_TOT);
    const f32x2* AT = (const f32x2*)(P.ws + OFF_AT); const f32x2* AT16 = (const f32x2*)(P.ws + OFF_AT16);
    for (int couple = blockIdx.x; couple < NSEQ * 64 / 2; couple += gridDim.x) {
        const int pair = couple * 2 + ps, seq = pair >> 6, g = pair & 63;
        __syncthreads();
        for (int rep = 0; rep < REPS(3); ++rep) {
        ssm_pass2<1, false>(P, UG, YP, Y, EP, seq, g, q, fr, fq);
        ssm_pass2<0, false>(P, UG, YP, Y, EP, seq, g, q, fr, fq); }
        const f32x2 aTf = AT[(0 * 64 + g) * 64 + lane], aTb = AT[(1 * 64 + g) * 64 + lane], aT16f = AT16[(0 * 64 + g) * 64 + lane], aT16b = AT16[(1 * 64 + g) * 64 + lane];
        TOT[((ps * 2 + 0) * 4 + q) * 64 + lane] = ssm_carry1<0>(EP, aTf, lane);
        TOT[((ps * 2 + 1) * 4 + q) * 64 + lane] = ssm_carry1<1>(EP + 1024, aTb, lane);
        __syncthreads();
        { f32x2 Hf = (f32x2){0.f, 0.f}, Hb = (f32x2){0.f, 0.f};
            for (int qq = 0; qq < q; ++qq) Hf = cmul(aT16f, Hf) + TOT[((ps * 2 + 0) * 4 + qq) * 64 + lane];
            for (int qq = 3; qq > q; --qq) Hb = cmul(aT16b, Hb) + TOT[((ps * 2 + 1) * 4 + qq) * 64 + lane];
            ssm_carry2<0>(EP, aTf, Hf, lane); ssm_carry2<1>(EP + 1024, aTb, Hb, lane); }
        asm volatile("s_waitcnt lgkmcnt(0)" ::: "memory");
        ssm_pass2<1, true>(P, UG, YP, Y, EP, seq, g, q, fr, fq);
        ssm_pass2<0, true>(P, UG, YP, Y, EP, seq, g, q, fr, fq);
    }
}

#define LAS __attribute__((address_space(3)))
constexpr size_t OFF_BAR = 458752;
constexpr int LDS_MISC_OFF = LDS_BYTES - 16;
#define XB_TMO      128
#define XB_XCNT(j)  (256  + 64 * (j))
#define XB_XSUB(j)  (1280 + 64 * (j))
#define XB_XGEN(j)  (2304 + 64 * (j))
#define XB_TOP      3328
#define XB_TOPGEN   3392
#define XCD_BAR_WORDS 3456
#define XB_SPIN_CAP (1u << 18)

__device__ __forceinline__ unsigned xb_ld(unsigned* p)              { return __hip_atomic_load(p, __ATOMIC_RELAXED, __HIP_MEMORY_SCOPE_AGENT); }
__device__ __forceinline__ unsigned xb_add(unsigned* p, unsigned v) { return __hip_atomic_fetch_add(p, v, __ATOMIC_RELAXED, __HIP_MEMORY_SCOPE_AGENT); }
__device__ __forceinline__ unsigned xb_xcc_id() { return (unsigned)__builtin_amdgcn_s_getreg((3 << 11) | 20) & 0xFu; }
#define XB_SPIN(cond, bar) do { unsigned _sp = 0; while (cond) { __builtin_amdgcn_s_sleep(1); \
    if ((++_sp & 255u) == 0u) { if (xb_ld(&(bar)[XB_TMO])) break; if (_sp > XB_SPIN_CAP) { atomicAdd(&(bar)[XB_TMO], 1u); break; } } } } while (0)

struct XcdBarrier {
    unsigned* bar; unsigned x;
    volatile LAS unsigned* st;
};

__device__ __forceinline__ XcdBarrier xcd_barrier_post(unsigned* bar, volatile LAS unsigned* st) {
    XcdBarrier b; b.bar = bar; b.x = xb_xcc_id(); b.st = st;
    if (threadIdx.x == 0) (void)xb_add(&bar[XB_XCNT(b.x)], 1u);
    return b;
}
__device__ __forceinline__ void xcd_barrier_complete(unsigned* bar, unsigned x, unsigned& nloc, unsigned& nx) {
    const unsigned G = gridDim.x * gridDim.y * gridDim.z;
    unsigned sum, cnt, mine, sp = 0u;
    for (;;) {
        sum = 0u; cnt = 0u; mine = 0u;
#pragma unroll
        for (unsigned j = 0; j < 16; ++j) { const unsigned c = xb_ld(&bar[XB_XCNT(j)]); sum += c; cnt += (c > 0u) ? 1u : 0u; mine = (j == x) ? c : mine; }
        if (sum == G) break;
        __builtin_amdgcn_s_sleep(1);
        if ((++sp & 255u) == 0u) { if (xb_ld(&bar[XB_TMO])) break; if (sp > XB_SPIN_CAP) { atomicAdd(&bar[XB_TMO], 1u); break; } }
    }
    nloc = mine > 0u ? mine : 1u; nx = cnt > 0u ? cnt : 1u;
}

__device__ __forceinline__ void xcd_barrier(const XcdBarrier& b) {
    asm volatile("s_waitcnt vmcnt(0)" ::: "memory");
    __syncthreads();
    if (threadIdx.x == 0) {
        unsigned* bar = b.bar;
        __builtin_amdgcn_s_waitcnt(0);
        unsigned nloc = b.st[0], nx = b.st[1];
        if (nloc == 0u) { xcd_barrier_complete(bar, b.x, nloc, nx); b.st[0] = nloc; b.st[1] = nx; }
        const unsigned old = xb_add(&bar[XB_XSUB(b.x)], 1u);
        const unsigned gen = old / nloc;
        if (old + 1u == (gen + 1u) * nloc) {
            __builtin_amdgcn_fence(__ATOMIC_RELEASE, "agent");
            asm volatile("s_waitcnt vmcnt(0)" ::: "memory");
            const unsigned og = xb_add(&bar[XB_TOP], 1u);
            const unsigned tg = og / nx;
            if (og + 1u == (tg + 1u) * nx) xb_add(&bar[XB_TOPGEN], 1u);
            else XB_SPIN(xb_ld(&bar[XB_TOPGEN]) == tg, bar);
            __builtin_amdgcn_fence(__ATOMIC_ACQUIRE, "agent");
            xb_add(&bar[XB_XGEN(b.x)], 1u);
            asm volatile("s_waitcnt vmcnt(0)" ::: "memory");
        } else {
            XB_SPIN(xb_ld(&bar[XB_XGEN(b.x)]) == gen, bar);
            __builtin_amdgcn_fence(__ATOMIC_ACQUIRE, "agent");
            asm volatile("s_waitcnt vmcnt(0)" ::: "memory");
        }
    }
    __syncthreads();
}

__global__ void __launch_bounds__(512, 2) fwd_megakernel(Params P) {
    extern __shared__ __attribute__((aligned(16))) unsigned char lds[];
    cg::grid_group grid = cg::this_grid();
    const int tid = threadIdx.x, lane = tid & 63, wave = __builtin_amdgcn_readfirstlane(tid >> 6);
    unsigned char* ws = P.ws;
    const int lo = P.ph_lo, hi = P.ph_hi;
#ifndef PHMASK
#define PHMASK 255
#endif
#define IN(k) (((PHMASK >> (k)) & 1) && lo <= (k) && (k) < hi)
#define SEAM(k) do { if (IN(k) && IN((k) + 1)) xcd_barrier(bar); } while (0)
    volatile LAS unsigned* MISC = (volatile LAS unsigned*)((LAS unsigned char*)lds + LDS_MISC_OFF);
    if (tid < 2) MISC[tid] = 0u;
    __syncthreads();
    const XcdBarrier bar = xcd_barrier_post((unsigned*)(ws + OFF_BAR), MISC);
    if (hi < 0) grid.sync();
    PG8_LAS unsigned char* ring = (PG8_LAS unsigned char*)lds;
    bf16* XB = (bf16*)(ws + OFF_XB); bf16* QKVU = (bf16*)(ws + OFF_QKVU); bf16* Y = (bf16*)(ws + OFF_Y); bf16* UPB = (bf16*)(ws + OFF_UP);
    bf16* GATES = (bf16*)P.out; float* ss2 = (float*)(ws + OFF_SS2);
    if (IN(0)) { for (int rep = 0; rep < REPS(0); ++rep) { p0_prologue(P, lds, tid, wave, lane); __syncthreads(); } }
    SEAM(0);
#ifdef EXTRA_SYNCS
    for (int i_ = 0; i_ < EXTRA_SYNCS; ++i_) xcd_barrier(bar);
#endif
    if (IN(1)) {
        pg8::Gemm gm{XB, (const bf16*)(ws + OFF_WIN), M, NIN, D}; pg8::StaticOrder S; S.init(M, NIN, gridDim.x, (int)blockIdx.x);
        EpiProj E{QKVU, (bf16*)(ws + OFF_UG), GATES};
        for (int rep = 0; rep < REPS(1); ++rep)
        pg8::gemm_phase<EpiProj, pg8::StaticOrder, true, true>(ring, gm, S, E);
    }
    SEAM(1);
    if (IN(2)) {
        attn_phase(P, lds, tid, wave, lane); __syncthreads();
        for (int rep = 0; rep < REPS(2); ++rep) ssm_phase(P, lds, tid, wave, lane);
    }
    SEAM(2);
    if (IN(4)) {
        pg8::Gemm gm{Y, (const bf16*)(ws + OFF_WGLU), M, D, D}; pg8::StaticOrder S; S.init(M, D, gridDim.x, (int)blockIdx.x);
        EpiGlu E{Y, QKVU, GATES + 1024, P.b_glu, XB};
        for (int rep = 0; rep < REPS(4); ++rep)
        pg8::gemm_phase<EpiGlu, pg8::StaticOrder, true, true>(ring, gm, S, E);
    }
    SEAM(4);
    if (IN(5)) {
        pg8::Gemm gm{XB, (const bf16*)(ws + OFF_WOUT), M, D, D}; pg8::StaticOrder S; S.init(M, D, gridDim.x, (int)blockIdx.x);
        EpiOut E{P.xp, P.xs, P.out, Y, ss2};
        pg8::gemm_phase<EpiOut, pg8::StaticOrder, true, true>(ring, gm, S, E);
    }
    SEAM(5);
    if (IN(6)) {
        pg8::Gemm gm{Y, (const bf16*)(ws + OFF_WUP), M, FF, D}; pg8::StaticOrder S; S.init(M, FF, gridDim.x, (int)blockIdx.x);
        EpiUp E{ss2, UPB};
        for (int rep = 0; rep < REPS(6); ++rep)
        pg8::gemm_phase<EpiUp, pg8::StaticOrder, true, true>(ring, gm, S, E);
    }
    SEAM(6);
    if (IN(7)) {
        pg8::Gemm gm{UPB, (const bf16*)(ws + OFF_WDN), M, D, FF}; pg8::StaticOrder S; S.init(M, D, gridDim.x, (int)blockIdx.x);
        EpiDown E{P.out, Y};
        pg8::gemm_phase<EpiDown, pg8::StaticOrder, true, true>(ring, gm, S, E);
    }
#undef IN
#undef SEAM
}

#ifndef MK_N_LAUNCHES
#define MK_N_LAUNCHES 1
#endif
extern "C" void kernel_launch(void* const* d_in, const int* in_sizes, int n_in, void* d_out, int out_size, void* d_ws, size_t ws_size, hipStream_t stream) {
    static int grid = 0;
    if (grid == 0) {
        if (n_in != 22 || out_size != M * D || ws_size < WS_NEED) { fprintf(stderr, "kernel_launch: unexpected shapes (n_in %d out %d ws %zu)\n", n_in, out_size, ws_size); grid = -1; return; }
        int dev = 0, cus = 0, per_cu = 0;
        hipGetDevice(&dev); hipDeviceGetAttribute(&cus, hipDeviceAttributeMultiprocessorCount, dev);
        if (hipFuncSetAttribute((const void*)fwd_megakernel, hipFuncAttributeMaxDynamicSharedMemorySize, LDS_BYTES) != hipSuccess) { fprintf(stderr, "kernel_launch: hipFuncSetAttribute failed\n"); grid = -1; return; }
        if (hipOccupancyMaxActiveBlocksPerMultiprocessor(&per_cu, (const void*)fwd_megakernel, 512, LDS_BYTES) != hipSuccess || per_cu < 1) { fprintf(stderr, "kernel_launch: occupancy query says %d\n", per_cu); per_cu = 1; }
        (void)hipGetLastError();
        grid = cus;
    }
    if (grid < 0) return;
    Params p{};
    const float** f = &p.xp;
    for (int i = 0; i < 22; ++i) f[i] = (const float*)d_in[i];
    p.out = (float*)d_out; p.ws = (unsigned char*)d_ws;
    if (hipMemsetAsync((char*)d_ws + OFF_BAR, 0, 16384, stream) != hipSuccess) { fprintf(stderr, "kernel_launch: hipMemsetAsync failed\n"); return; }
    if (MK_N_LAUNCHES == 1) {
        p.ph_lo = 0; p.ph_hi = 8;
        void* args[] = {&p};
        hipError_t e = hipLaunchCooperativeKernel((const void*)fwd_megakernel, dim3(grid), dim3(512), args, LDS_BYTES, stream);
        if (e != hipSuccess) fprintf(stderr, "cooperative launch failed: %s (grid %d)\n", hipGetErrorString(e), grid);
    } else {
        for (int ph = 0; ph < 8; ++ph) { p.ph_lo = ph; p.ph_hi = ph + 1;
            void* args[] = {&p};
            hipError_t e = hipLaunchCooperativeKernel((const void*)fwd_megakernel, dim3(grid), dim3(512), args, LDS_BYTES, stream);
            if (e != hipSuccess) { fprintf(stderr, "launch %d failed: %s\n", ph, hipGetErrorString(e)); break; } }
    }
}
```

```cpp
#include <hip/hip_runtime.h>
#include <hip/hip_cooperative_groups.h>
#include <cstdio>
#include <cstdint>
namespace cg = cooperative_groups;
namespace pg8 {
#define PG8_LAS __attribute__((address_space(3)))
typedef unsigned short bf16_t;
typedef short bf16x8 __attribute__((ext_vector_type(8)));
typedef float f32x4 __attribute__((ext_vector_type(4)));
typedef unsigned u32x4 __attribute__((ext_vector_type(4)));
constexpr int BM = 256, BK = 64, HALF = 128, HTB = HALF * BK * 2  , STAGE_BYTES = 8 * HTB, NXCD = 8, WGM = 8;

__host__ __device__ __forceinline__ int lds_byte(int r, int c) { const int st = (r >> 4) * 2 + (c >> 5), rr = r & 15, cc = c & 31, ob = rr * 64 + cc * 2; return st * 1024 + (ob ^ (((ob >> 9) & 1) << 5)); }
__host__ __device__ __forceinline__ void stage_rc(int b, int& R, int& C) { const int st = b / 1024, sb = b % 1024, swz = sb ^ (((sb >> 9) & 1) << 5); R = (st >> 1) * 16 + swz / 64; C = (st & 1) * 32 + (swz % 64) / 2; }
__host__ __device__ __forceinline__ int perm32(int rho) { const int n = rho >> 4, i = rho & 15; return 8 * (i >> 2) + 4 * n + (i & 3); }

struct Unit { int pm, pn; };
struct Gemm { const bf16_t* A; const bf16_t* Bt; int M, N, K; };

struct StaticOrder {
    int nM, nN, nwg, G, c;
    __host__ __device__ void init(int M, int N, int G_, int c_) { nM = M / BM; nN = N / BM; nwg = nM * nN; G = G_; c = c_; }
    __host__ __device__ bool next(int i, Unit& u) const {
        const long L = (long)i * G + c; if (L >= nwg) return false;
        int wgid = (int)L; { const int q = nwg / NXCD, r = nwg % NXCD, xcd = wgid % NXCD, off = wgid / NXCD; wgid = (xcd < r ? xcd * (q + 1) : r * (q + 1) + (xcd - r) * q) + off; }
        const int nig = WGM * nN, gid = wgid / nig, fm = gid * WGM, gsz = (nM - fm) < WGM ? (nM - fm) : WGM;
        u.pm = fm + ((wgid % nig) % gsz); u.pn = (wgid % nig) / gsz; return true;
    }
    __device__ __forceinline__ void a_ready(const Unit&) const {}
    __device__ __forceinline__ void done(const Unit&) const {}
};
__device__ __forceinline__ unsigned cvt_pk_bf16(float lo, float hi) { unsigned r; asm volatile("v_cvt_pk_bf16_f32 %0, %1, %2" : "=v"(r) : "v"(lo), "v"(hi)); return r; }
typedef float f32x2 __attribute__((ext_vector_type(2)));
template <class Epi, class Sched, bool ALIGN_EPI = false, bool SP2 = false>
__device__ __forceinline__ void gemm_phase(PG8_LAS unsigned char* lds, const Gemm g, const Sched& S, const Epi& E) {
    const int tid = threadIdx.x, wid = __builtin_amdgcn_readfirstlane(tid >> 6), lane = tid & 63, wr = wid >> 2, wc = wid & 3, fr = lane & 15, fq = lane >> 4;
    const int K = g.K, nt = K / BK;
    unsigned voffA[2], voffB[2];
#pragma unroll
    for (int i = 0; i < 2; ++i) { int R, C; stage_rc(tid * 16 + i * 8192, R, C); const int Rb = Epi::PERM ? ((R & ~31) + perm32(R & 31)) : R;
        voffA[i] = (unsigned)(R * K + C) * 2u; voffB[i] = (unsigned)(Rb * K + C) * 2u; }
    const size_t kstep = (size_t)(BK * 2);
    const size_t hstep = (size_t)HALF * K * 2;
    const size_t tstep = 2 * hstep;
    const unsigned ldsw = (unsigned)wid * 1024u;
    const int aoff = lds_byte(wr * 64 + fr, fq * 8), boff = lds_byte(wc * 32 + fr, fq * 8);
#define PG8_SA(b, h) (((b) * 2 + (h)) * HTB)
#define PG8_SB(b, h) ((4 + (b) * 2 + (h)) * HTB)
#define PG8_STAGE(bufoff, gbase, voff) do { _Pragma("unroll") for (int _i = 0; _i < 2; ++_i) \
        __builtin_amdgcn_global_load_lds((const unsigned*)((const char*)(gbase) + (voff)[_i]), (PG8_LAS unsigned*)(lds + (bufoff) + ldsw + _i * 8192), 16, 0, 0); } while (0)
#define PG8_LDA(dst, b, h) do { _Pragma("unroll") for (int m = 0; m < 4; ++m) _Pragma("unroll") for (int k = 0; k < 2; ++k) dst[m][k] = *(const PG8_LAS bf16x8*)(lds + PG8_SA(b, h) + aoff + m * 2048 + k * 1024); } while (0)
#define PG8_LDB(dst, b, h) do { _Pragma("unroll") for (int n = 0; n < 2; ++n) _Pragma("unroll") for (int k = 0; k < 2; ++k) dst[n][k] = *(const PG8_LAS bf16x8*)(lds + PG8_SB(b, h) + boff + n * 2048 + k * 1024); } while (0)
#define PG8_MMA(ai, bj, At, Bt) do { __builtin_amdgcn_s_setprio(1); _Pragma("unroll") for (int m = 0; m < 4; ++m) _Pragma("unroll") for (int n = 0; n < 2; ++n) _Pragma("unroll") for (int k = 0; k < 2; ++k) \
        acc[ai][bj][m][n] = __builtin_amdgcn_mfma_f32_16x16x32_bf16(Bt[n][k], At[m][k], acc[ai][bj][m][n], 0, 0, 0); __builtin_amdgcn_s_setprio(0); } while (0)
#define PG8_WAIT_V(n) asm volatile("s_waitcnt vmcnt(" #n ")" ::: "memory")
#define PG8_WAIT_L(n) asm volatile("s_waitcnt lgkmcnt(" #n ")" ::: "memory")
#define PG8_BAR __builtin_amdgcn_s_barrier()
#define PG8_SCHED __builtin_amdgcn_sched_barrier(0)
    Unit cur, nxt; int ui = 0;
    if (!S.next(0, cur)) return;
    f32x4 acc[2][2][4][2];
#pragma unroll
    for (int a = 0; a < 2; ++a)
#pragma unroll
        for (int b = 0; b < 2; ++b)
#pragma unroll
            for (int m = 0; m < 4; ++m)
#pragma unroll
                for (int n = 0; n < 2; ++n) acc[a][b][m][n] = (f32x4){0.f, 0.f, 0.f, 0.f};
    bf16x8 At[4][2], B0[2][2], B1[2][2];
    const char* cA = (const char*)g.A + (size_t)cur.pm * tstep; const char* cB = (const char*)g.Bt + (size_t)cur.pn * tstep;
    S.a_ready(cur);
    if constexpr (SP2) {
        PG8_STAGE(PG8_SB(0, 0), cB, voffB); PG8_STAGE(PG8_SB(0, 1), cB + hstep, voffB); PG8_STAGE(PG8_SA(0, 0), cA, voffA); PG8_STAGE(PG8_SA(0, 1), cA + hstep, voffA);
        if (wr == 1) PG8_BAR;
        PG8_WAIT_V(2); PG8_BAR;
        PG8_STAGE(PG8_SB(1, 0), cB + kstep, voffB); PG8_STAGE(PG8_SA(1, 0), cA + kstep, voffA); PG8_STAGE(PG8_SB(1, 1), cB + hstep + kstep, voffB);
        PG8_WAIT_V(6); PG8_BAR;
    } else {
        PG8_STAGE(PG8_SB(0, 0), cB, voffB); PG8_STAGE(PG8_SA(0, 0), cA, voffA); PG8_STAGE(PG8_SB(0, 1), cB + hstep, voffB); PG8_STAGE(PG8_SA(0, 1), cA + hstep, voffA);
        if (wr == 1) PG8_BAR;
        PG8_WAIT_V(4); PG8_BAR;
        PG8_STAGE(PG8_SB(1, 0), cB + kstep, voffB); PG8_STAGE(PG8_SA(1, 0), cA + kstep, voffA); PG8_STAGE(PG8_SB(1, 1), cB + hstep + kstep, voffB);
        PG8_WAIT_V(6); PG8_BAR;
    }
    for (;;) {
        const bool has_next = S.next(ui + 1, nxt);
        const char* nA = has_next ? (const char*)g.A + (size_t)nxt.pm * tstep : cA; const char* nB = has_next ? (const char*)g.Bt + (size_t)nxt.pn * tstep : cB;
        for (int t = 0; t < nt; t += 2) {
            const bool last = (t == nt - 2);
            const char* a1 = cA + (size_t)(t + 1) * kstep;
            const char* a2 = last ? nA : cA + (size_t)(t + 2) * kstep; const char* b2 = last ? nB : cB + (size_t)(t + 2) * kstep;
            const char* a3 = a2 + kstep; const char* b3 = b2 + kstep;
            if (last && has_next) S.a_ready(nxt);
            if constexpr (SP2) {
            PG8_LDB(B0, 0, 0); PG8_LDB(B1, 0, 1); PG8_SCHED; PG8_LDA(At, 0, 0); PG8_STAGE(PG8_SA(1, 1), a1 + hstep, voffA);
            PG8_WAIT_V(8); PG8_WAIT_L(0); PG8_BAR; PG8_MMA(0, 0, At, B0); PG8_MMA(0, 1, At, B1); PG8_BAR; PG8_SCHED;
            PG8_LDA(At, 0, 1); PG8_STAGE(PG8_SB(0, 0), b2, voffB); PG8_STAGE(PG8_SB(0, 1), b2 + hstep, voffB); PG8_STAGE(PG8_SA(0, 0), a2, voffA);
            PG8_WAIT_V(8); PG8_WAIT_L(0); PG8_BAR; PG8_MMA(1, 0, At, B0); PG8_MMA(1, 1, At, B1); PG8_BAR; PG8_SCHED;
            PG8_LDB(B0, 1, 0); PG8_LDB(B1, 1, 1); PG8_SCHED; PG8_LDA(At, 1, 0); PG8_STAGE(PG8_SA(0, 1), a2 + hstep, voffA);
            PG8_WAIT_V(8); PG8_WAIT_L(0); PG8_BAR; PG8_MMA(0, 0, At, B0); PG8_MMA(0, 1, At, B1); PG8_BAR; PG8_SCHED;
            PG8_LDA(At, 1, 1); PG8_STAGE(PG8_SB(1, 0), b3, voffB); PG8_STAGE(PG8_SB(1, 1), b3 + hstep, voffB); PG8_STAGE(PG8_SA(1, 0), a3, voffA);
            PG8_WAIT_V(8); PG8_WAIT_L(0); PG8_BAR; PG8_MMA(1, 0, At, B0); PG8_MMA(1, 1, At, B1); PG8_BAR; PG8_SCHED;
            } else {
            PG8_LDB(B0, 0, 0); PG8_SCHED; PG8_LDA(At, 0, 0); PG8_STAGE(PG8_SA(1, 1), a1 + hstep, voffA);
            PG8_WAIT_L(8); PG8_BAR; PG8_WAIT_L(0); PG8_MMA(0, 0, At, B0); PG8_BAR; PG8_SCHED;
            PG8_LDB(B1, 0, 1); PG8_STAGE(PG8_SB(0, 0), b2, voffB);
            PG8_BAR; PG8_WAIT_L(0); PG8_MMA(0, 1, At, B1); PG8_BAR;
            PG8_LDA(At, 0, 1); PG8_STAGE(PG8_SA(0, 0), a2, voffA);
            PG8_BAR; PG8_WAIT_L(0); PG8_MMA(1, 0, At, B0); PG8_BAR; PG8_SCHED;
            PG8_STAGE(PG8_SB(0, 1), b2 + hstep, voffB);
            PG8_WAIT_V(6); PG8_BAR; PG8_MMA(1, 1, At, B1); PG8_BAR;
            PG8_LDB(B0, 1, 0); PG8_SCHED; PG8_LDA(At, 1, 0); PG8_STAGE(PG8_SA(0, 1), a2 + hstep, voffA);
            PG8_WAIT_L(8); PG8_BAR; PG8_WAIT_L(0); PG8_MMA(0, 0, At, B0); PG8_BAR; PG8_SCHED;
            PG8_LDB(B1, 1, 1); PG8_STAGE(PG8_SB(1, 0), b3, voffB);
            PG8_BAR; PG8_WAIT_L(0); PG8_MMA(0, 1, At, B1); PG8_BAR;
            PG8_LDA(At, 1, 1); PG8_STAGE(PG8_SA(1, 0), a3, voffA);
            PG8_BAR; PG8_WAIT_L(0); PG8_MMA(1, 0, At, B0); PG8_BAR; PG8_SCHED;
            PG8_STAGE(PG8_SB(1, 1), b3 + hstep, voffB);
            PG8_WAIT_V(6); PG8_BAR; PG8_MMA(1, 1, At, B1); PG8_BAR;
            }
        }
        if constexpr (ALIGN_EPI) { if (wr == 0) PG8_BAR; }
        if constexpr (!Epi::AFTER_DRAIN) { E(acc, cur, wr, wc, fr, fq); S.done(cur); }
        if (!has_next) break;
#pragma unroll
        for (int a = 0; a < 2; ++a)
#pragma unroll
            for (int b = 0; b < 2; ++b)
#pragma unroll
                for (int m = 0; m < 4; ++m)
#pragma unroll
                    for (int n = 0; n < 2; ++n) acc[a][b][m][n] = (f32x4){0.f, 0.f, 0.f, 0.f};
        cur = nxt; cA = nA; cB = nB; ++ui;
        if constexpr (ALIGN_EPI) { if (wr == 1) PG8_BAR; }
    }
    PG8_WAIT_V(0);
    if constexpr (!ALIGN_EPI) { if (wr == 0) PG8_BAR; }
    PG8_BAR;
    if constexpr (Epi::AFTER_DRAIN) { E.fused(acc, cur, wr, wc, fr, fq, lds, wid, lane); S.done(cur); }
#undef PG8_SA
#undef PG8_SB
#undef PG8_STAGE
#undef PG8_LDA
#undef PG8_LDB
#undef PG8_MMA
#undef PG8_WAIT_V
#undef PG8_WAIT_L
#undef PG8_BAR
#undef PG8_SCHED
}
}

constexpr int D = 1024, NSEQ = 24, L = 4096, M = NSEQ * L, NIN = 4608, FF = 4096, MP = 8 * 4096;
constexpr int LDQ = 1536;
constexpr int LDG = 2048;
constexpr float EPS = 1e-6f, LOG2E = 1.4426950408889634f;
constexpr size_t MiB = 1u << 20;
constexpr size_t OFF_SS2 = 0, OFF_M0 = 393216, OFF_AP = 524288, OFF_AT = 589824, OFF_AT16 = 655360, OFF_BB = 720896, OFF_CF = 1245184;
constexpr size_t OFF_WIN = 2 * MiB, OFF_WGLU = 11 * MiB, OFF_WOUT = 13 * MiB, OFF_WUP = 15 * MiB, OFF_WDN = 23 * MiB;
constexpr size_t OFF_Y = 40 * MiB, OFF_XB = 232 * MiB, OFF_QKVU = 424 * MiB, OFF_UG = 712 * MiB, OFF_BBA = 31 * MiB, OFF_CAF = 31 * MiB + 524288, OFF_K0 = 32 * MiB, OFF_UP = 232 * MiB, WS_NEED = 1000 * MiB;
constexpr int LDS_BYTES = 147456;
#ifndef REPMASK
#define REPMASK 0
#endif
#define REPS(k) (((REPMASK >> (k)) & 1) ? 2 : 1)

typedef unsigned short bf16;
typedef short bf16x8 __attribute__((ext_vector_type(8)));
typedef short s16x4 __attribute__((ext_vector_type(4)));
typedef float f32x4 __attribute__((ext_vector_type(4)));
typedef float f32x2 __attribute__((ext_vector_type(2)));
typedef unsigned u32x4 __attribute__((ext_vector_type(4)));
typedef unsigned u32x2 __attribute__((ext_vector_type(2)));

__device__ __forceinline__ unsigned f2bf(float f) { unsigned u = __builtin_bit_cast(unsigned, f); return (u + 0x7fffu + ((u >> 16) & 1u)) >> 16; }
typedef __bf16 bf16x2_t __attribute__((ext_vector_type(2)));
__device__ __forceinline__ unsigned pk2(float lo, float hi) { const f32x2 v = {lo, hi}; const bf16x2_t b = __builtin_convertvector(v, bf16x2_t); return __builtin_bit_cast(unsigned, b); }
__device__ __forceinline__ unsigned pk2v(f32x2 v) { const bf16x2_t b = __builtin_convertvector(v, bf16x2_t); return __builtin_bit_cast(unsigned, b); }
__device__ __forceinline__ float bflo(unsigned w) { return __builtin_bit_cast(float, w << 16); }
__device__ __forceinline__ float bfhi(unsigned w) { return __builtin_bit_cast(float, w & 0xffff0000u); }
__device__ __forceinline__ float fsigmoid(float x) { return __builtin_amdgcn_rcpf(1.0f + __builtin_amdgcn_exp2f(-LOG2E * x)); }
__device__ __forceinline__ float wave_sum(float v) {
#pragma unroll
    for (int o = 1; o < 64; o <<= 1) v += __shfl_xor(v, o);
    return v;
}

struct Params {
    const float *xp, *xs, *rel_table, *ln1, *w_in, *q_gain, *k_gain, *sink, *lam_re, *lam_im, *log_dt, *b_re, *b_im, *c_re, *c_im, *d_skip, *w_glu, *b_glu, *w_out, *ln2, *w_up, *w_down;
    float* out; unsigned char* ws; int ph_lo, ph_hi;
};

using pg8::Unit; using pg8::HALF; using pg8::BM;
struct EpiProj {
    static constexpr bool PERM = true, AFTER_DRAIN = false;
    bf16* QKV; bf16* UG; bf16* GATES;
    __device__ __forceinline__ void operator()(const f32x4 (&acc)[2][2][4][2], const Unit& u, int wr, int wc, int fr, int fq) const {
        const int row0 = u.pm * BM + wr * 64 + fr, col0 = wc * 32 + 8 * fq;
        if (u.pn >= 6 && u.pn < 10) {
            const int c0 = (u.pn - 6) * 256 + col0;
#pragma unroll
            for (int ai = 0; ai < 2; ++ai)
#pragma unroll
                for (int m = 0; m < 4; ++m) { const size_t row = (size_t)(row0 + ai * HALF + m * 16);
#pragma unroll
                    for (int bj = 0; bj < 2; ++bj) { const int c = c0 + bj * HALF; const f32x4 v0 = acc[ai][bj][m][0], v1 = acc[ai][bj][m][1];
                        u32x4 w; w.x = pk2(v0[0], v0[1]); w.y = pk2(v0[2], v0[3]); w.z = pk2(v1[0], v1[1]); w.w = pk2(v1[2], v1[3]);
                        *(u32x4*)(UG + ((size_t)(c >> 4) * M + row) * 16 + (c & 15)) = w; } }
            return;
        }
        if (u.pn >= 10) {
            unsigned char* gb = (unsigned char*)GATES + (u.pn - 10) * 256 + col0;
#pragma unroll
            for (int ai = 0; ai < 2; ++ai)
#pragma unroll
                for (int m = 0; m < 4; ++m) { unsigned char* rowp = gb + (size_t)(row0 + ai * HALF + m * 16) * 2048;
#pragma unroll
                    for (int bj = 0; bj < 2; ++bj) { const f32x4 v0 = acc[ai][bj][m][0], v1 = acc[ai][bj][m][1]; unsigned w0 = 0u, w1 = 0u;
#pragma unroll
                        for (int e = 0; e < 4; ++e) { w0 |= (unsigned)(fsigmoid(v0[e]) * 255.0f + 0.5f) << (8 * e); w1 |= (unsigned)(fsigmoid(v1[e]) * 255.0f + 0.5f) << (8 * e); }
                        *(u32x2*)(rowp + bj * HALF) = (u32x2){w0, w1}; } }
            return;
        }
        const bool gate = false;
        bf16* base = QKV + u.pn * 256;
        const int ldc = LDQ;
#pragma unroll
        for (int ai = 0; ai < 2; ++ai)
#pragma unroll
            for (int m = 0; m < 4; ++m) { bf16* rowp = base + (size_t)(row0 + ai * HALF + m * 16) * ldc + col0;
#pragma unroll
                for (int bj = 0; bj < 2; ++bj) { f32x4 v0 = acc[ai][bj][m][0], v1 = acc[ai][bj][m][1];
                    if (gate) {
#pragma unroll
                        for (int e = 0; e < 4; ++e) { v0[e] = fsigmoid(v0[e]); v1[e] = fsigmoid(v1[e]); } }
                    u32x4 w; w.x = pk2(v0[0], v0[1]); w.y = pk2(v0[2], v0[3]); w.z = pk2(v1[0], v1[1]); w.w = pk2(v1[2], v1[3]);
                    *(u32x4*)(rowp + bj * HALF) = w; } }
    }
};
struct EpiGlu {
    static constexpr bool PERM = true, AFTER_DRAIN = false;
    const bf16* Y; const bf16* ATTG; const bf16* GS; const float* bglu; bf16* MIXED;
    __device__ __forceinline__ void operator()(const f32x4 (&acc)[2][2][4][2], const Unit& u, int wr, int wc, int fr, int fq) const {
        const int row0 = u.pm * BM + wr * 64 + fr, col0 = u.pn * BM + wc * 32 + 8 * fq;
#pragma unroll
        for (int bj = 0; bj < 2; ++bj) {
            const int col = col0 + bj * HALF;
            const f32x4 b0 = *(const f32x4*)(bglu + col), b1 = *(const f32x4*)(bglu + col + 4);
#pragma unroll
            for (int ai = 0; ai < 2; ++ai) {
                u32x4 yv[4], av[4]; u32x2 gv[4];
#pragma unroll
                for (int m = 0; m < 4; ++m) { const size_t row = (size_t)(row0 + ai * HALF + m * 16);
                    yv[m] = *(const u32x4*)(Y + row * D + col); av[m] = *(const u32x4*)(ATTG + row * LDQ + col); gv[m] = *(const u32x2*)((const unsigned char*)GS + row * 2048 + col); }
#pragma unroll
                for (int m = 0; m < 4; ++m) { const size_t row = (size_t)(row0 + ai * HALF + m * 16);
                    const f32x4 z0 = acc[ai][bj][m][0] + b0, z1 = acc[ai][bj][m][1] + b1;
                    float r[8];
#pragma unroll
                    for (int e = 0; e < 4; ++e) { const float z = e < 2 ? z0[2 * e] : z1[2 * (e - 2)], zz = e < 2 ? z0[2 * e + 1] : z1[2 * (e - 2) + 1];
                        const unsigned gw = e < 2 ? gv[m].x : gv[m].y; const int sh = 16 * (e & 1);
                        r[2 * e] = bflo(av[m][e]) + (float)((gw >> sh) & 255u) * (1.0f / 255.0f) * bflo(yv[m][e]) * fsigmoid(z);
                        r[2 * e + 1] = bfhi(av[m][e]) + (float)((gw >> (sh + 8)) & 255u) * (1.0f / 255.0f) * bfhi(yv[m][e]) * fsigmoid(zz); }
                    u32x4 w; w.x = pk2(r[0], r[1]); w.y = pk2(r[2], r[3]); w.z = pk2(r[4], r[5]); w.w = pk2(r[6], r[7]);
                    *(u32x4*)(MIXED + row * D + col) = w; } } }
    }
};
struct EpiOut {
    static constexpr bool PERM = true, AFTER_DRAIN = false;
    const float* xp; const float* xs; float* out; bf16* X1B; float* ss2;
    __device__ __forceinline__ void operator()(const f32x4 (&acc)[2][2][4][2], const Unit& u, int wr, int wc, int fr, int fq) const {
        const int row0 = u.pm * BM + wr * 64 + fr, col0 = u.pn * BM + wc * 32 + 8 * fq;
        const float* xb = (u.pm * BM < MP) ? xp : xs - (size_t)MP * D;
#pragma unroll
        for (int ai = 0; ai < 2; ++ai)
#pragma unroll
            for (int mh = 0; mh < 2; ++mh) {
                f32x4 xv[2][2][2];
#pragma unroll
                for (int mm = 0; mm < 2; ++mm)
#pragma unroll
                    for (int bj = 0; bj < 2; ++bj) { const size_t off = (size_t)(row0 + ai * HALF + (2 * mh + mm) * 16) * D + col0 + bj * HALF;
                        xv[mm][bj][0] = *(const f32x4*)(xb + off); xv[mm][bj][1] = *(const f32x4*)(xb + off + 4); }
#pragma unroll
                for (int mm = 0; mm < 2; ++mm) { const int m = 2 * mh + mm; const size_t row = (size_t)(row0 + ai * HALF + m * 16); float ssq = 0.f;
#pragma unroll
                    for (int bj = 0; bj < 2; ++bj) { const size_t off = row * D + col0 + bj * HALF;
                        const f32x4 v0 = acc[ai][bj][m][0] + xv[mm][bj][0], v1 = acc[ai][bj][m][1] + xv[mm][bj][1];
                        ssq += (v0[0] * v0[0] + v0[1] * v0[1]) + (v0[2] * v0[2] + v0[3] * v0[3]) + (v1[0] * v1[0] + v1[1] * v1[1]) + (v1[2] * v1[2] + v1[3] * v1[3]);
                        u32x4 w; w.x = pk2(v0[0], v0[1]); w.y = pk2(v0[2], v0[3]); w.z = pk2(v1[0], v1[1]); w.w = pk2(v1[2], v1[3]);
                        *(u32x4*)(X1B + off) = w; }
                    ssq += __shfl_xor(ssq, 16); ssq += __shfl_xor(ssq, 32);
                    if (fq == 0) atomicAdd(ss2 + row, ssq); } }
    }
};
struct EpiUp {
    static constexpr bool PERM = true, AFTER_DRAIN = false;
    const float* ss2; bf16* UP;
    __device__ __forceinline__ void operator()(const f32x4 (&acc)[2][2][4][2], const Unit& u, int wr, int wc, int fr, int fq) const {
        const int row0 = u.pm * BM + wr * 64 + fr, col0 = u.pn * BM + wc * 32 + 8 * fq;
#pragma unroll
        for (int ai = 0; ai < 2; ++ai)
#pragma unroll
            for (int m = 0; m < 4; ++m) { const size_t row = (size_t)(row0 + ai * HALF + m * 16);
                const float r2 = __builtin_amdgcn_rsqf(ss2[row] * (1.0f / D) + EPS);
#pragma unroll
                for (int bj = 0; bj < 2; ++bj) { f32x4 v0 = acc[ai][bj][m][0] * r2, v1 = acc[ai][bj][m][1] * r2;
#pragma unroll
                    for (int e = 0; e < 4; ++e) { const float a = fmaxf(v0[e], 0.f), b = fmaxf(v1[e], 0.f); v0[e] = a * a; v1[e] = b * b; }
                    u32x4 w; w.x = pk2(v0[0], v0[1]); w.y = pk2(v0[2], v0[3]); w.z = pk2(v1[0], v1[1]); w.w = pk2(v1[2], v1[3]);
                    *(u32x4*)(UP + row * FF + col0 + bj * HALF) = w; } }
    }
};
struct EpiDown {
    static constexpr bool PERM = true, AFTER_DRAIN = false;
    float* out; const bf16* X1B;
    __device__ __forceinline__ void operator()(const f32x4 (&acc)[2][2][4][2], const Unit& u, int wr, int wc, int fr, int fq) const {
        const int row0 = u.pm * BM + wr * 64 + fr, col0 = u.pn * BM + wc * 32 + 8 * fq;
#pragma unroll
        for (int ai = 0; ai < 2; ++ai) {
            u32x4 xv[4][2];
#pragma unroll
            for (int m = 0; m < 4; ++m)
#pragma unroll
                for (int bj = 0; bj < 2; ++bj) xv[m][bj] = *(const u32x4*)(X1B + (size_t)(row0 + ai * HALF + m * 16) * D + col0 + bj * HALF);
#pragma unroll
            for (int m = 0; m < 4; ++m)
#pragma unroll
                for (int bj = 0; bj < 2; ++bj) { float* p = out + (size_t)(row0 + ai * HALF + m * 16) * D + col0 + bj * HALF; const u32x4 x = xv[m][bj];
                    *(f32x4*)p = acc[ai][bj][m][0] + (f32x4){bflo(x.x), bfhi(x.x), bflo(x.y), bfhi(x.y)};
                    *(f32x4*)(p + 4) = acc[ai][bj][m][1] + (f32x4){bflo(x.z), bfhi(x.z), bflo(x.w), bfhi(x.w)}; } }
    }
};

__device__ __forceinline__ void transpose_item(const float* W, int K, int N, bf16* WT, const float* kscale, float* scr, int item, int lane) {
    const int nblk = N / 32, kb = item / nblk, nb = item % nblk, k0 = 64 * kb, n0 = 32 * nb;
    float tv[32];
#pragma unroll
    for (int i = 0; i < 32; ++i) tv[i] = W[(size_t)(k0 + 2 * i + (lane >> 5)) * N + n0 + (lane & 31)];
#pragma unroll
    for (int i = 0; i < 32; ++i) { const int kk = 2 * i + (lane >> 5); float v = tv[i]; if (kscale) v *= kscale[k0 + kk]; scr[kk * 33 + (lane & 31)] = v; }
    asm volatile("s_waitcnt lgkmcnt(0)" ::: "memory");
    const int c = lane & 7;
#pragma unroll
    for (int j = 0; j < 4; ++j) { const int n = (lane >> 3) + 8 * j; const float* s = scr + (8 * c) * 33 + n;
        u32x4 o; o.x = pk2(s[0 * 33], s[1 * 33]); o.y = pk2(s[2 * 33], s[3 * 33]); o.z = pk2(s[4 * 33], s[5 * 33]); o.w = pk2(s[6 * 33], s[7 * 33]);
        *(u32x4*)(WT + (size_t)(n0 + n) * K + k0 + 8 * c) = o; }
    asm volatile("s_waitcnt lgkmcnt(0)" ::: "memory");
}
__device__ __forceinline__ void sincos_d(double x, double& s, double& c) {
    const double k = __builtin_rint(x * 0.63661977236758134308), r = (x - k * 1.5707963267948966) - k * 6.123233995736766e-17, r2 = r * r;
    double sp = 1.0, cp = 1.0;
#pragma unroll
    for (int i = 10; i >= 1; --i) { sp = 1.0 - sp * r2 / (double)((2 * i) * (2 * i + 1)); cp = 1.0 - cp * r2 / (double)((2 * i - 1) * (2 * i)); }
    sp *= r;
    const int q = ((int)k) & 3;
    s = (q == 0) ? sp : (q == 1) ? cp : (q == 2) ? -sp : -cp;
    c = (q == 0) ? cp : (q == 1) ? -sp : (q == 2) ? -cp : sp;
}
__device__ __forceinline__ void ssm_disc(const Params& P, int dg, int p, double& are, double& aim, double& cre, double& cim) {
    const double dt = exp((double)P.log_dt[dg]);
    const double lr = (double)P.lam_re[dg * 64 + p], li = (double)P.lam_im[dg * 64 + p];
    const double mag = exp(lr * dt); double sn, cs; sincos_d(li * dt, sn, cs);
    are = mag * cs; aim = mag * sn;
    const double den = lr * lr + li * li, nr = are - 1.0, ni = aim;
    cre = (nr * lr + ni * li) / den; cim = (ni * lr - nr * li) / den;
}
__device__ __forceinline__ void ssm_prep(const Params& P, int dg, int lane, float* scr) {
    unsigned char* ws = P.ws;
    const int p = lane;
    double are, aim, cre, cim; ssm_disc(P, dg, p, are, aim, cre, cim);
    ((f32x2*)(ws + OFF_AP))[dg * 64 + p] = (f32x2){(float)are, (float)aim};
    double pr = are, pi = aim;
#pragma unroll 1
    for (int i = 0; i < 10; ++i) { const double nr_ = pr * pr - pi * pi, ni_ = 2.0 * pr * pi; pr = nr_; pi = ni_;
        if (i == 5) ((f32x2*)(ws + OFF_AT))[dg * 64 + p] = (f32x2){(float)pr, (float)pi}; }
    ((f32x2*)(ws + OFF_AT16))[dg * 64 + p] = (f32x2){(float)pr, (float)pi};
    bf16* BB = (bf16*)(ws + OFF_BB); bf16* BBA = (bf16*)(ws + OFF_BBA);
#pragma unroll 4
    for (int c = 0; c < 16; ++c) { const double br = (double)P.b_re[(size_t)(dg * 64 + p) * 16 + c], bi = (double)P.b_im[(size_t)(dg * 64 + p) * 16 + c];
        const double bbr = cre * br - cim * bi, bbi = cre * bi + cim * br;
        BB[((size_t)(dg * 2 + 0) * 64 + p) * 16 + c] = (bf16)f2bf((float)bbr);
        BB[((size_t)(dg * 2 + 1) * 64 + p) * 16 + c] = (bf16)f2bf((float)bbi);
        BBA[((size_t)(dg * 2 + 0) * 64 + p) * 16 + c] = (bf16)f2bf((float)(are * bbr - aim * bbi));
        BBA[((size_t)(dg * 2 + 1) * 64 + p) * 16 + c] = (bf16)f2bf((float)(are * bbi + aim * bbr));
        scr[(p * 16 + c) * 2] = (float)bbr; scr[(p * 16 + c) * 2 + 1] = (float)bbi; }
    scr[2048 + 2 * p] = (float)are; scr[2048 + 2 * p + 1] = (float)aim;
    asm volatile("s_waitcnt lgkmcnt(0)" ::: "memory");
    bf16* CF = (bf16*)(ws + OFF_CF); bf16* CAF = (bf16*)(ws + OFF_CAF);
    for (int e = lane; e < 2048; e += 64) { const int jj = e & 7, fq = (e >> 3) & 3, c = (e >> 5) & 15, s = e >> 9;
        const int pp = 16 * (2 * (s & 1) + (jj >> 2)) + 4 * fq + (jj & 3);
        const float v = (s < 2) ? P.c_re[(size_t)(dg * 16 + c) * 64 + pp] : -P.c_im[(size_t)(dg * 16 + c) * 64 + pp];
        CF[(size_t)dg * 2048 + e] = (bf16)f2bf(v);
        const float cr = P.c_re[(size_t)(dg * 16 + c) * 64 + pp], ci = P.c_im[(size_t)(dg * 16 + c) * 64 + pp], ar_ = scr[2048 + 2 * pp], ai_ = scr[2048 + 2 * pp + 1];
        CAF[(size_t)dg * 2048 + e] = (bf16)f2bf((s < 2) ? cr * ar_ - ci * ai_ : -(cr * ai_ + ci * ar_)); }
    bf16* K0 = (bf16*)(ws + OFF_K0);
    { const int co = lane >> 2, cin0 = (lane & 3) * 4; float acc[4] = {0.f, 0.f, 0.f, 0.f};
#pragma unroll 8
        for (int pp = 0; pp < 64; ++pp) { const float cr = P.c_re[(size_t)(dg * 16 + co) * 64 + pp], ci = P.c_im[(size_t)(dg * 16 + co) * 64 + pp];
#pragma unroll
            for (int i = 0; i < 4; ++i) acc[i] += cr * scr[(pp * 16 + cin0 + i) * 2] - ci * scr[(pp * 16 + cin0 + i) * 2 + 1]; }
        *(u32x2*)(K0 + (size_t)dg * 256 + lane * 4) = (u32x2){pk2(acc[0], acc[1]), pk2(acc[2], acc[3])}; }
    asm volatile("s_waitcnt lgkmcnt(0)" ::: "memory");
}
__device__ __forceinline__ void p0_prologue(const Params& P, unsigned char* lds, int tid, int wave, int lane) {
    unsigned char* ws = P.ws;
    float* scr = (float*)(lds + wave * 16384);
    const int gw = blockIdx.x * 8 + wave, NGW = gridDim.x * 8;
    constexpr int I_IN = 16 * (NIN / 32), I_G = 16 * 32, I_UP = 16 * (FF / 32), I_DN = (FF / 64) * 32;
    constexpr int NITEMS = I_IN + 2 * I_G + I_UP + I_DN;
    for (int it = gw; it < NITEMS; it += NGW) {
        int r = it;
        if (r < I_IN) { transpose_item(P.w_in, D, NIN, (bf16*)(ws + OFF_WIN), nullptr, scr, r, lane); continue; } r -= I_IN;
        if (r < I_G) { transpose_item(P.w_glu, D, D, (bf16*)(ws + OFF_WGLU), nullptr, scr, r, lane); continue; } r -= I_G;
        if (r < I_G) { transpose_item(P.w_out, D, D, (bf16*)(ws + OFF_WOUT), nullptr, scr, r, lane); continue; } r -= I_G;
        if (r < I_UP) { transpose_item(P.w_up, D, FF, (bf16*)(ws + OFF_WUP), P.ln2, scr, r, lane); continue; } r -= I_UP;
        transpose_item(P.w_down, FF, D, (bf16*)(ws + OFF_WDN), nullptr, scr, r, lane);
    }
    if (wave == 7) for (int dg = blockIdx.x; dg < 128; dg += gridDim.x) ssm_prep(P, dg, lane, scr);
    if (blockIdx.x == gridDim.x - 1 && wave == 6) {
        float gq = fabsf(P.q_gain[lane]), gk = fabsf(P.k_gain[lane]);
#pragma unroll
        for (int o = 1; o < 64; o <<= 1) { gq = fmaxf(gq, __shfl_xor(gq, o)); gk = fmaxf(gk, __shfl_xor(gk, o)); }
        if (lane < 16) { float bm = 0.f; for (int b = 0; b < 32; ++b) bm = fmaxf(bm, fabsf(P.rel_table[b * 16 + lane]));
            ((float*)(ws + OFF_M0))[lane] = fmaxf((8.0f * gq * gk * 1.0001f + bm) * LOG2E, P.sink[lane] * LOG2E); }
    }
    float* ss2 = (float*)(ws + OFF_SS2);
    for (int i = blockIdx.x * 512 + tid; i < M; i += gridDim.x * 512) ss2[i] = 0.f;
    f32x4 gl[4];
#pragma unroll
    for (int j = 0; j < 4; ++j) gl[j] = ((const f32x4*)P.ln1)[lane + 64 * j];
    bf16* XB = (bf16*)(ws + OFF_XB);
    f32x4 v[4], vn[4], vnn[4];
    auto xrp = [&](int m) { return (const f32x4*)((m < MP) ? P.xp + (size_t)m * D : P.xs + (size_t)(m - MP) * D) + lane; };
    if (gw < M) { const f32x4* xr = xrp(gw);
#pragma unroll
        for (int j = 0; j < 4; ++j) v[j] = xr[64 * j]; }
    if (gw + NGW < M) { const f32x4* xr = xrp(gw + NGW);
#pragma unroll
        for (int j = 0; j < 4; ++j) vn[j] = xr[64 * j]; }
    for (int m = gw; m < M; m += NGW) {
        const int mnn = m + 2 * NGW;
        if (mnn < M) { const f32x4* xr = xrp(mnn);
#pragma unroll
            for (int j = 0; j < 4; ++j) vnn[j] = xr[64 * j]; }
        float s = 0.f;
#pragma unroll
        for (int j = 0; j < 4; ++j) s += (v[j].x * v[j].x + v[j].y * v[j].y) + (v[j].z * v[j].z + v[j].w * v[j].w);
        const float rstd = 1.0f / sqrtf(wave_sum(s) * (1.f / D) + EPS);
        u32x2* o8 = (u32x2*)(XB + (size_t)m * D) + lane;
#pragma unroll
        for (int j = 0; j < 4; ++j) { const f32x4 t = v[j] * rstd * gl[j]; o8[64 * j] = (u32x2){pk2(t.x, t.y), pk2(t.z, t.w)}; }
#pragma unroll
        for (int j = 0; j < 4; ++j) { v[j] = vn[j]; vn[j] = vnn[j]; }
    }
}

constexpr int KST = 72;
constexpr int AT_K = 0, AT_V = 2 * 64 * KST * 2, AT_TB = 4 * 64 * KST * 2, AT_Q = AT_TB + 8192;
__device__ __forceinline__ void attn_phase(const Params& P, unsigned char* lds, int tid_in, int w, int lane_in) {
    bf16* QKVU = (bf16*)(P.ws + OFF_QKVU);
    const bf16* GATES = (const bf16*)P.out;
    const int g = w >> 1, qh = w & 1;
    float* tb = (float*)(lds + AT_TB);
    int tb_kh = -1;
    for (int item = blockIdx.x; item < NSEQ * 32 * 4; item += gridDim.x) {
        int lane = lane_in; asm volatile("" : "+v"(lane));
        const int tid = w * 64 + lane, fr = lane & 15, fq = lane >> 4;
        const int kh = item & 3, n = (item >> 2) & 31, seq = item >> 7, h = kh * 4 + g;
        const size_t m0 = (size_t)seq * L + n * 128;
        __syncthreads();
        if (kh != tb_kh) {
            tb_kh = kh;
            for (int e = tid; e < 4 * 512; e += 512) { const int gg = e >> 9, idx = e & 511, rel = idx - 255; float v = -1e30f;
                if (rel >= -128 && rel <= 128) { const int na = rel < 0 ? -rel : rel;
                    int b = na < 8 ? na : 8 + (na >= 12) + (na >= 16) + (na >= 23) + (na >= 32) + (na >= 46) + (na >= 64) + (na >= 91);
                    b += rel > 0 ? 16 : 0; v = P.rel_table[b * 16 + kh * 4 + gg] * LOG2E - ((const float*)(P.ws + OFF_M0))[kh * 4 + gg]; }
                tb[e] = v; }
        }
        const int c_lo = (n == 0) ? 2 : 0, c_hi = (n == 31) ? 4 : 6;
        u32x4 kreg, vreg;
        auto gload = [&](int c) {
            const size_t mk = m0 - 128 + 64 * c;
            kreg = *(const u32x4*)(QKVU + (mk + (tid >> 3)) * LDQ + 1024 + kh * 64 + 8 * (tid & 7));
            vreg = *(const u32x4*)(QKVU + (mk + lane) * LDQ + 1280 + kh * 64 + 8 * w);
        };
        bf16x8* Qs = (bf16x8*)(lds + AT_Q + w * 8192) + lane;
#pragma unroll
        for (int qg = 0; qg < 4; ++qg)
#pragma unroll
            for (int ks = 0; ks < 2; ++ks)
                __builtin_amdgcn_global_load_lds((const unsigned*)(QKVU + (m0 + 64 * qh + 16 * qg + fr) * LDQ + h * 64 + 32 * ks + 8 * fq),
                                                 (PG8_LAS unsigned*)((PG8_LAS unsigned char*)lds + AT_Q + w * 8192 + (qg * 2 + ks) * 1024), 16, 0, 0);
        gload(c_lo);
        asm volatile("s_waitcnt vmcnt(0)" ::: "memory");
        {
            float gq[2][8];
#pragma unroll
            for (int ks = 0; ks < 2; ++ks)
#pragma unroll
                for (int j = 0; j < 8; ++j) gq[ks][j] = P.q_gain[32 * ks + 8 * fq + j] * (0.125f * LOG2E);
#pragma unroll 1
            for (int qg = 0; qg < 4; ++qg) {
                const u32x4 r0 = __builtin_bit_cast(u32x4, Qs[(qg * 2 + 0) * 64]), r1 = __builtin_bit_cast(u32x4, Qs[(qg * 2 + 1) * 64]);
                float f[2][8]; float ss = 0.f;
#pragma unroll
                for (int e = 0; e < 4; ++e) { f[0][2 * e] = bflo(r0[e]); f[0][2 * e + 1] = bfhi(r0[e]); f[1][2 * e] = bflo(r1[e]); f[1][2 * e + 1] = bfhi(r1[e]); }
#pragma unroll
                for (int j = 0; j < 8; ++j) ss += f[0][j] * f[0][j] + f[1][j] * f[1][j];
                ss += __shfl_xor(ss, 16); ss += __shfl_xor(ss, 32);
                const float rn = 1.0f / sqrtf(ss * (1.f / 64) + EPS);
#pragma unroll
                for (int ks = 0; ks < 2; ++ks) { u32x4 o;
#pragma unroll
                    for (int e = 0; e < 4; ++e) o[e] = pk2(f[ks][2 * e] * rn * gq[ks][2 * e], f[ks][2 * e + 1] * rn * gq[ks][2 * e + 1]);
                    Qs[(qg * 2 + ks) * 64] = __builtin_bit_cast(bf16x8, o); }
            }
        }
        const float sinkp = __builtin_amdgcn_exp2f(P.sink[h] * LOG2E - ((const float*)(P.ws + OFF_M0))[h]);
        f32x4 O[4][4]; float lrow[4];
#pragma unroll
        for (int qg = 0; qg < 4; ++qg) { lrow[qg] = (fq == 0) ? sinkp : 0.f;
#pragma unroll
            for (int dt = 0; dt < 4; ++dt) O[qg][dt] = (f32x4){0.f, 0.f, 0.f, 0.f}; }
        auto lstore = [&](int buf) {
            float f[8]; float ss = 0.f; float gk[8];
#pragma unroll
            for (int j = 0; j < 8; ++j) gk[j] = P.k_gain[8 * (tid & 7) + j];
#pragma unroll
            for (int e = 0; e < 4; ++e) { f[2 * e] = bflo(kreg[e]); f[2 * e + 1] = bfhi(kreg[e]); }
#pragma unroll
            for (int j = 0; j < 8; ++j) ss += f[j] * f[j];
            ss += __shfl_xor(ss, 1); ss += __shfl_xor(ss, 2); ss += __shfl_xor(ss, 4);
            const float rn = 1.0f / sqrtf(ss * (1.f / 64) + EPS);
            u32x4 o;
#pragma unroll
            for (int e = 0; e < 4; ++e) o[e] = pk2(f[2 * e] * rn * gk[2 * e], f[2 * e + 1] * rn * gk[2 * e + 1]);
            *(u32x4*)(lds + AT_K + buf * (64 * KST * 2) + ((tid >> 3) * KST + 8 * (tid & 7)) * 2) = o;
            bf16* vt = (bf16*)(lds + AT_V + buf * (64 * KST * 2));
#pragma unroll
            for (int e = 0; e < 4; ++e) { vt[(8 * w + 2 * e) * KST + lane] = (bf16)(vreg[e] & 0xffffu); vt[(8 * w + 2 * e + 1) * KST + lane] = (bf16)(vreg[e] >> 16); }
        };
        lstore(0);
        __syncthreads();
        for (int c = c_lo; c < c_hi; ++c) {
            const int buf = (c - c_lo) & 1;
            if (c + 1 < c_hi) gload(c + 1);
            const bool skip = (qh == 0 && c == 5) || (qh == 1 && c == 0);
            if (!skip) {
                const unsigned char* kb = lds + AT_K + buf * (64 * KST * 2);
                const unsigned char* vb = lds + AT_V + buf * (64 * KST * 2);
                bf16x8 Kf[4][2];
#pragma unroll
                for (int t = 0; t < 4; ++t)
#pragma unroll
                    for (int ks = 0; ks < 2; ++ks) Kf[t][ks] = *(const bf16x8*)(kb + ((16 * t + fr) * KST + 32 * ks + 8 * fq) * 2);
#pragma unroll
                for (int qg = 0; qg < 4; ++qg) {
                    f32x4 S[4];
                    __builtin_amdgcn_sched_barrier(0);
                    const bf16x8 Qf0 = Qs[(qg * 2 + 0) * 64], Qf1 = Qs[(qg * 2 + 1) * 64];
#pragma unroll
                    for (int t = 0; t < 4; ++t) { S[t] = (f32x4){0.f, 0.f, 0.f, 0.f};
#pragma unroll
                        for (int ks = 0; ks < 2; ++ks) S[t] = __builtin_amdgcn_mfma_f32_16x16x32_bf16(Kf[t][ks], ks == 0 ? Qf0 : Qf1, S[t], 0, 0, 0); }
                    const int q = 64 * qh + 16 * qg + fr;
                    const float* tbp = tb + g * 512 + (64 * c - 128 + 4 * fq - q + 255);
                    float rs = 0.f;
#pragma unroll
                    for (int t = 0; t < 4; ++t)
#pragma unroll
                        for (int j = 0; j < 4; ++j) { S[t][j] = __builtin_amdgcn_exp2f(S[t][j] + tbp[16 * t + j]); rs += S[t][j]; }
                    lrow[qg] += rs;
                    bf16x8 Pf[2];
#pragma unroll
                    for (int s = 0; s < 2; ++s) { u32x4 o; o.x = pk2(S[2 * s][0], S[2 * s][1]); o.y = pk2(S[2 * s][2], S[2 * s][3]); o.z = pk2(S[2 * s + 1][0], S[2 * s + 1][1]); o.w = pk2(S[2 * s + 1][2], S[2 * s + 1][3]);
                        Pf[s] = __builtin_bit_cast(bf16x8, o); }
                    __builtin_amdgcn_sched_barrier(0);
#pragma unroll
                    for (int dt = 0; dt < 4; ++dt)
#pragma unroll
                        for (int s = 0; s < 2; ++s) { const s16x4 lo = *(const s16x4*)(vb + ((16 * dt + fr) * KST + 32 * s + 4 * fq) * 2), hi = *(const s16x4*)(vb + ((16 * dt + fr) * KST + 32 * s + 16 + 4 * fq) * 2);
                            const bf16x8 Vf = (bf16x8){lo[0], lo[1], lo[2], lo[3], hi[0], hi[1], hi[2], hi[3]};
                            O[qg][dt] = __builtin_amdgcn_mfma_f32_16x16x32_bf16(Vf, Pf[s], O[qg][dt], 0, 0, 0); }
                }
            }
            if (c + 1 < c_hi) lstore(buf ^ 1);
            __syncthreads();
        }
        unsigned gv[4][4];
#pragma unroll
        for (int qg = 0; qg < 4; ++qg)
#pragma unroll
            for (int dt = 0; dt < 4; ++dt) gv[qg][dt] = *(const unsigned*)((const unsigned char*)GATES + (m0 + 64 * qh + 16 * qg + fr) * 2048 + h * 64 + 16 * dt + 4 * fq);
#pragma unroll
        for (int qg = 0; qg < 4; ++qg) {
            float lt = lrow[qg]; lt += __shfl_xor(lt, 16); lt += __shfl_xor(lt, 32);
            const float inv = (1.0f / 255.0f) / lt;
            const size_t row = m0 + 64 * qh + 16 * qg + fr;
#pragma unroll
            for (int dt = 0; dt < 4; ++dt) { const int col = h * 64 + 16 * dt + 4 * fq;
                const f32x4 o = O[qg][dt] * inv;
                const unsigned gw = gv[qg][dt];
                *(u32x2*)(QKVU + row * LDQ + col) = (u32x2){pk2(o[0] * (float)(gw & 255u), o[1] * (float)((gw >> 8) & 255u)), pk2(o[2] * (float)((gw >> 16) & 255u), o[3] * (float)(gw >> 24))}; }
        }
    }
}

constexpr int SS_TOT = 131072;
__device__ __forceinline__ float gelu_tanh(float x) {
    const float t = x + 0.044715f * x * x * x;
    return x * __builtin_amdgcn_rcpf(1.0f + __builtin_amdgcn_exp2f(-2.0f * 0.7978845608028654f * LOG2E * t));
}
__device__ __forceinline__ f32x2 gelu_tanh2(f32x2 x) {
    const f32x2 x2 = x * x, t = x * (x2 * 0.044715f + 1.0f), a = t * (-2.0f * 0.7978845608028654f * LOG2E);
    f32x2 e; e.x = __builtin_amdgcn_exp2f(a.x); e.y = __builtin_amdgcn_exp2f(a.y);
    const f32x2 d = e + 1.0f; f32x2 r; r.x = __builtin_amdgcn_rcpf(d.x); r.y = __builtin_amdgcn_rcpf(d.y);
    return x * r;
}
__device__ __forceinline__ f32x2 cmul(f32x2 a, f32x2 b);
template <int DIR>
__device__ __forceinline__ void ssm_emit(f32x4 y, u32x2 ulo, unsigned long long ybv, f32x4 dsk, u32x2* yp) {
    if (DIR == 1) { *yp = (u32x2){pk2(y[0], y[1]), pk2(y[2], y[3])}; }
    else {
        const unsigned yl = (unsigned)ybv, yh = (unsigned)(ybv >> 32);
        const f32x2 ya = (f32x2){y[0], y[1]} + (f32x2){bflo(yl), bfhi(yl)} + (f32x2){dsk[0], dsk[1]} * (f32x2){bflo(ulo.x), bfhi(ulo.x)};
        const f32x2 yb = (f32x2){y[2], y[3]} + (f32x2){bflo(yh), bfhi(yh)} + (f32x2){dsk[2], dsk[3]} * (f32x2){bflo(ulo.y), bfhi(ulo.y)};
        *yp = (u32x2){pk2v(gelu_tanh2(ya)), pk2v(gelu_tanh2(yb))};
    }
}
template <int DIR, bool OUT>
__device__ __forceinline__ void ssm_pair(const bf16x8 (&Bf2)[4][2], const bf16x8 (&Cf)[4], const bf16x8 (&CAf)[4], s16x4 K0f, const f32x2 (&a2r)[4][2], const f32x2 (&a2i)[4][2],
                                         f32x2 (&hr)[4][2], f32x2 (&hi)[4][2], bf16x8 (&hB)[4], u32x2 u1, u32x2 u2, unsigned long long yb1, unsigned long long yb2, f32x4 dsk, u32x2* yp1, u32x2* yp2) {
    const f32x4 z = (f32x4){0.f, 0.f, 0.f, 0.f};
    f32x4 y1 = z;
    if (OUT) {
        const u32x2 k0_ = __builtin_bit_cast(u32x2, K0f);
        y1 = __builtin_amdgcn_mfma_f32_16x16x32_bf16(__builtin_bit_cast(bf16x8, ((u32x4){k0_.x, k0_.y, 0u, 0u})), __builtin_bit_cast(bf16x8, ((u32x4){u1.x, u1.y, 0u, 0u})), z, 0, 0, 0);
#pragma unroll
        for (int s = 0; s < 4; ++s) y1 = __builtin_amdgcn_mfma_f32_16x16x32_bf16(CAf[s], hB[s], y1, 0, 0, 0); }
    const bf16x8 uB = __builtin_bit_cast(bf16x8, ((u32x4){u1.x, u1.y, u2.x, u2.y}));
#pragma unroll
    for (int pt = 0; pt < 4; ++pt) {
        const f32x4 br = __builtin_amdgcn_mfma_f32_16x16x32_bf16(Bf2[pt][0], uB, z, 0, 0, 0);
        const f32x4 bi = __builtin_amdgcn_mfma_f32_16x16x32_bf16(Bf2[pt][1], uB, z, 0, 0, 0);
#pragma unroll
        for (int jj = 0; jj < 2; ++jj) { const f32x2 brp = (f32x2){br[2 * jj], br[2 * jj + 1]}, bip = (f32x2){bi[2 * jj], bi[2 * jj + 1]}, r0 = hr[pt][jj], i0 = hi[pt][jj];
            hr[pt][jj] = a2r[pt][jj] * r0 - a2i[pt][jj] * i0 + brp;
            hi[pt][jj] = a2r[pt][jj] * i0 + a2i[pt][jj] * r0 + bip; }
    }
    if (!OUT) return;
    ssm_emit<DIR>(y1, u1, yb1, dsk, yp1);
    f32x4 y2 = z;
#pragma unroll
    for (int s = 0; s < 4; ++s) { const int p0 = 2 * (s & 1); u32x4 o;
        if (s < 2) { o.x = pk2v(hr[p0][0]); o.y = pk2v(hr[p0][1]); o.z = pk2v(hr[p0 + 1][0]); o.w = pk2v(hr[p0 + 1][1]); }
        else       { o.x = pk2v(hi[p0][0]); o.y = pk2v(hi[p0][1]); o.z = pk2v(hi[p0 + 1][0]); o.w = pk2v(hi[p0 + 1][1]); }
        hB[s] = __builtin_bit_cast(bf16x8, o);
        y2 = __builtin_amdgcn_mfma_f32_16x16x32_bf16(Cf[s], hB[s], y2, 0, 0, 0); }
    ssm_emit<DIR>(y2, u2, yb2, dsk, yp2);
}
template <int DIR, bool OUT>
__device__ __forceinline__ void ssm_pass2(const Params& P, const bf16* UG, bf16* YP, bf16* Y, f32x2* EP, int seq, int g, int q, int fr_in, int fq_in) {
    int fr = fr_in, fq = fq_in; asm volatile("" : "+v"(fr), "+v"(fq));
    const int dg = DIR * 64 + g;
    const bf16* BB = (const bf16*)(P.ws + OFF_BB); const bf16* BBA = (const bf16*)(P.ws + OFF_BBA); const f32x2* AP = (const f32x2*)(P.ws + OFF_AP);
    const bf16* CF = (const bf16*)(P.ws + OFF_CF); const bf16* CAF = (const bf16*)(P.ws + OFF_CAF); const bf16* K0 = (const bf16*)(P.ws + OFF_K0);
    bf16x8 Bf2[4][2], Cf[4], CAf[4], hB[4]; f32x2 a2r[4][2], a2i[4][2], hr[4][2], hi[4][2];
#pragma unroll
    for (int pt = 0; pt < 4; ++pt) {
#pragma unroll
        for (int ri = 0; ri < 2; ++ri) { const size_t o_ = ((size_t)(dg * 2 + ri) * 64 + 16 * pt + fr) * 16 + 4 * fq; const u32x2 lo = *(const u32x2*)(BBA + o_), hi2 = *(const u32x2*)(BB + o_);
            Bf2[pt][ri] = __builtin_bit_cast(bf16x8, ((u32x4){lo.x, lo.y, hi2.x, hi2.y})); }
#pragma unroll
        for (int jj = 0; jj < 2; ++jj) { const f32x2 a0 = AP[dg * 64 + 16 * pt + 4 * fq + 2 * jj], a1 = AP[dg * 64 + 16 * pt + 4 * fq + 2 * jj + 1], s0 = cmul(a0, a0), s1 = cmul(a1, a1);
            a2r[pt][jj] = (f32x2){s0.x, s1.x}; a2i[pt][jj] = (f32x2){s0.y, s1.y};
            if (OUT) { const f32x2 e0 = EP[DIR * 1024 + (16 * pt + 4 * fq + 2 * jj) * 16 + fr], e1 = EP[DIR * 1024 + (16 * pt + 4 * fq + 2 * jj + 1) * 16 + fr]; hr[pt][jj] = (f32x2){e0.x, e1.x}; hi[pt][jj] = (f32x2){e0.y, e1.y}; }
            else { hr[pt][jj] = (f32x2){0.f, 0.f}; hi[pt][jj] = (f32x2){0.f, 0.f}; } }
    }
#pragma unroll
    for (int s = 0; s < 4; ++s) { if (!OUT) { Cf[s] = (bf16x8){0, 0, 0, 0, 0, 0, 0, 0}; CAf[s] = Cf[s]; hB[s] = Cf[s]; continue; }
        Cf[s] = *(const bf16x8*)(CF + (size_t)dg * 2048 + ((s * 16 + fr) * 4 + fq) * 8); CAf[s] = *(const bf16x8*)(CAF + (size_t)dg * 2048 + ((s * 16 + fr) * 4 + fq) * 8);
        const int p0 = 2 * (s & 1); u32x4 o;
        if (s < 2) { o.x = pk2v(hr[p0][0]); o.y = pk2v(hr[p0][1]); o.z = pk2v(hr[p0 + 1][0]); o.w = pk2v(hr[p0 + 1][1]); }
        else       { o.x = pk2v(hi[p0][0]); o.y = pk2v(hi[p0][1]); o.z = pk2v(hi[p0 + 1][0]); o.w = pk2v(hi[p0 + 1][1]); }
        hB[s] = __builtin_bit_cast(bf16x8, o); }
    s16x4 K0f = (s16x4){0, 0, 0, 0}; if (OUT) K0f = *(const s16x4*)(K0 + (size_t)dg * 256 + fr * 16 + 4 * fq);
    f32x4 dsk = (f32x4){0.f, 0.f, 0.f, 0.f};
    if (OUT && DIR == 0) dsk = *(const f32x4*)(P.d_skip + 16 * g + 4 * fq);
    const size_t rowu = (size_t)seq * L + 64 * 16 * q;
    const bf16* Ub = UG + ((size_t)g * M + rowu) * 16;
    bf16* Pb = YP + ((size_t)g * M + rowu) * 16;
    bf16* Yb = Y + rowu * D + 16 * g;
    const unsigned og = (unsigned)(64 * fr * 16 + 4 * fq) / 4, oy = (unsigned)(64 * fr * D + 4 * fq) / 4;
    constexpr bool NEEDY = OUT && DIR == 0;
    u32x2 bU[2][4]; unsigned long long bY[2][4];
#define TAU(st) (DIR == 0 ? (st) : 63 - (st))
#define SSM_LOAD(B, blk) do { _Pragma("unroll") for (int k_ = 0; k_ < 4; ++k_) { const int tau_ = TAU((blk) * 4 + k_); \
        bU[B][k_] = ((const u32x2*)(Ub + (size_t)tau_ * 16))[og]; \
        if (NEEDY) bY[B][k_] = __hip_atomic_load((const unsigned long long*)(Pb + (size_t)tau_ * 16) + og, __ATOMIC_RELAXED, __HIP_MEMORY_SCOPE_AGENT); } } while (0)
#define YPTR(st) (DIR == 1 ? (u32x2*)(Pb + (size_t)TAU(st) * 16) + og : (u32x2*)(Yb + (size_t)TAU(st) * D) + oy)
#define SSM_PAIRS(B, blk) do { _Pragma("unroll") for (int k_ = 0; k_ < 4; k_ += 2) { const int st_ = (blk) * 4 + k_; __builtin_amdgcn_sched_barrier(0); \
        ssm_pair<DIR, OUT>(Bf2, Cf, CAf, K0f, a2r, a2i, hr, hi, hB, bU[B][k_], bU[B][k_ + 1], NEEDY ? bY[B][k_] : 0ull, NEEDY ? bY[B][k_ + 1] : 0ull, dsk, YPTR(st_), YPTR(st_ + 1)); } } while (0)
    SSM_LOAD(0, 0);
#pragma unroll 1
    for (int b = 0; b < 16; b += 2) {
        SSM_LOAD(1, b + 1);
        __builtin_amdgcn_sched_barrier(0);
        SSM_PAIRS(0, b);
        if (b + 2 < 16) SSM_LOAD(0, b + 2);
        __builtin_amdgcn_sched_barrier(0);
        SSM_PAIRS(1, b + 1);
    }
#undef SSM_LOAD
#undef SSM_PAIRS
#undef YPTR
#undef TAU
    if (!OUT) {
#pragma unroll
        for (int pt = 0; pt < 4; ++pt)
#pragma unroll
            for (int jj = 0; jj < 2; ++jj) { EP[DIR * 1024 + (16 * pt + 4 * fq + 2 * jj) * 16 + fr] = (f32x2){hr[pt][jj].x, hi[pt][jj].x}; EP[DIR * 1024 + (16 * pt + 4 * fq + 2 * jj + 1) * 16 + fr] = (f32x2){hr[pt][jj].y, hi[pt][jj].y}; }
    }
    asm volatile("s_waitcnt vmcnt(0) lgkmcnt(0)" ::: "memory");
}
__device__ __forceinline__ f32x2 cmul(f32x2 a, f32x2 b) { return (f32x2){a.x * b.x - a.y * b.y, a.x * b.y + a.y * b.x}; }
template <int DIR>
__device__ __forceinline__ f32x2 ssm_carry1(f32x2* EPd, f32x2 aT, int lane) {
    f32x2 e[16];
#pragma unroll
    for (int kk = 0; kk < 16; ++kk) e[kk] = EPd[lane * 16 + kk];
    f32x2 acc = (f32x2){0.f, 0.f};
#pragma unroll
    for (int i = 0; i < 16; ++i) { const int kk = DIR == 0 ? i : 15 - i; EPd[lane * 16 + kk] = acc; acc = cmul(aT, acc) + e[kk]; }
    return acc;
}
template <int DIR>
__device__ __forceinline__ void ssm_carry2(f32x2* EPd, f32x2 aT, f32x2 Hq, int lane) {
    f32x2 e[16];
#pragma unroll
    for (int kk = 0; kk < 16; ++kk) e[kk] = EPd[lane * 16 + kk];
    f32x2 pw = Hq;
#pragma unroll
    for (int i = 0; i < 16; ++i) { const int kk = DIR == 0 ? i : 15 - i; EPd[lane * 16 + kk] = e[kk] + pw; pw = cmul(aT, pw); }
}
__device__ __forceinline__ void ssm_phase(const Params& P, unsigned char* lds, int tid, int w, int lane) {
    const bf16* UG = (const bf16*)(P.ws + OFF_UG);
    bf16* Y = (bf16*)(P.ws + OFF_Y); bf16* YP = (bf16*)(P.ws + OFF_XB);
    const int fr = lane & 15, fq = lane >> 4, q = w & 3, ps = w >> 2;
    f32x2* EP = (f32x2*)(lds + w * 16384);
    f32x2* TOT = (f32x2*)(lds + SS_TOT);
    const f32x2* AT = (const f32x2*)(P.ws + OFF_AT); const f32x2* AT16 = (const f32x2*)(P.ws + OFF_AT16);
    for (int couple = blockIdx.x; couple < NSEQ * 64 / 2; couple += gridDim.x) {
        const int pair = couple * 2 + ps, seq = pair >> 6, g = pair & 63;
        __syncthreads();
        for (int rep = 0; rep < REPS(3); ++rep) {
        ssm_pass2<1, false>(P, UG, YP, Y, EP, seq, g, q, fr, fq);
        ssm_pass2<0, false>(P, UG, YP, Y, EP, seq, g, q, fr, fq); }
        const f32x2 aTf = AT[(0 * 64 + g) * 64 + lane], aTb = AT[(1 * 64 + g) * 64 + lane], aT16f = AT16[(0 * 64 + g) * 64 + lane], aT16b = AT16[(1 * 64 + g) * 64 + lane];
        TOT[((ps * 2 + 0) * 4 + q) * 64 + lane] = ssm_carry1<0>(EP, aTf, lane);
        TOT[((ps * 2 + 1) * 4 + q) * 64 + lane] = ssm_carry1<1>(EP + 1024, aTb, lane);
        __syncthreads();
        { f32x2 Hf = (f32x2){0.f, 0.f}, Hb = (f32x2){0.f, 0.f};
            for (int qq = 0; qq < q; ++qq) Hf = cmul(aT16f, Hf) + TOT[((ps * 2 + 0) * 4 + qq) * 64 + lane];
            for (int qq = 3; qq > q; --qq) Hb = cmul(aT16b, Hb) + TOT[((ps * 2 + 1) * 4 + qq) * 64 + lane];
            ssm_carry2<0>(EP, aTf, Hf, lane); ssm_carry2<1>(EP + 1024, aTb, Hb, lane); }
        asm volatile("s_waitcnt lgkmcnt(0)" ::: "memory");
        ssm_pass2<1, true>(P, UG, YP, Y, EP, seq, g, q, fr, fq);
        ssm_pass2<0, true>(P, UG, YP, Y, EP, seq, g, q, fr, fq);
    }
}

#define LAS __attribute__((address_space(3)))
constexpr size_t OFF_BAR = 458752;
constexpr int LDS_MISC_OFF = LDS_BYTES - 16;
#define XB_TMO      128
#define XB_XCNT(j)  (256  + 64 * (j))
#define XB_XSUB(j)  (1280 + 64 * (j))
#define XB_XGEN(j)  (2304 + 64 * (j))
#define XB_TOP      3328
#define XB_TOPGEN   3392
#define XCD_BAR_WORDS 3456
#define XB_SPIN_CAP (1u << 18)

__device__ __forceinline__ unsigned xb_ld(unsigned* p)              { return __hip_atomic_load(p, __ATOMIC_RELAXED, __HIP_MEMORY_SCOPE_AGENT); }
__device__ __forceinline__ unsigned xb_add(unsigned* p, unsigned v) { return __hip_atomic_fetch_add(p, v, __ATOMIC_RELAXED, __HIP_MEMORY_SCOPE_AGENT); }
__device__ __forceinline__ unsigned xb_xcc_id() { return (unsigned)__builtin_amdgcn_s_getreg((3 << 11) | 20) & 0xFu; }
#define XB_SPIN(cond, bar) do { unsigned _sp = 0; while (cond) { __builtin_amdgcn_s_sleep(1); \
    if ((++_sp & 255u) == 0u) { if (xb_ld(&(bar)[XB_TMO])) break; if (_sp > XB_SPIN_CAP) { atomicAdd(&(bar)[XB_TMO], 1u); break; } } } } while (0)

struct XcdBarrier {
    unsigned* bar; unsigned x;
    volatile LAS unsigned* st;
};

__device__ __forceinline__ XcdBarrier xcd_barrier_post(unsigned* bar, volatile LAS unsigned* st) {
    XcdBarrier b; b.bar = bar; b.x = xb_xcc_id(); b.st = st;
    if (threadIdx.x == 0) (void)xb_add(&bar[XB_XCNT(b.x)], 1u);
    return b;
}
__device__ __forceinline__ void xcd_barrier_complete(unsigned* bar, unsigned x, unsigned& nloc, unsigned& nx) {
    const unsigned G = gridDim.x * gridDim.y * gridDim.z;
    unsigned sum, cnt, mine, sp = 0u;
    for (;;) {
        sum = 0u; cnt = 0u; mine = 0u;
#pragma unroll
        for (unsigned j = 0; j < 16; ++j) { const unsigned c = xb_ld(&bar[XB_XCNT(j)]); sum += c; cnt += (c > 0u) ? 1u : 0u; mine = (j == x) ? c : mine; }
        if (sum == G) break;
        __builtin_amdgcn_s_sleep(1);
        if ((++sp & 255u) == 0u) { if (xb_ld(&bar[XB_TMO])) break; if (sp > XB_SPIN_CAP) { atomicAdd(&bar[XB_TMO], 1u); break; } }
    }
    nloc = mine > 0u ? mine : 1u; nx = cnt > 0u ? cnt : 1u;
}

__device__ __forceinline__ void xcd_barrier(const XcdBarrier& b) {
    asm volatile("s_waitcnt vmcnt(0)" ::: "memory");
    __syncthreads();
    if (threadIdx.x == 0) {
        unsigned* bar = b.bar;
        __builtin_amdgcn_s_waitcnt(0);
        unsigned nloc = b.st[0], nx = b.st[1];
        if (nloc == 0u) { xcd_barrier_complete(bar, b.x, nloc, nx); b.st[0] = nloc; b.st[1] = nx; }
        const unsigned old = xb_add(&bar[XB_XSUB(b.x)], 1u);
        const unsigned gen = old / nloc;
        if (old + 1u == (gen + 1u) * nloc) {
            __builtin_amdgcn_fence(__ATOMIC_RELEASE, "agent");
            asm volatile("s_waitcnt vmcnt(0)" ::: "memory");
            const unsigned og = xb_add(&bar[XB_TOP], 1u);
            const unsigned tg = og / nx;
            if (og + 1u == (tg + 1u) * nx) xb_add(&bar[XB_TOPGEN], 1u);
            else XB_SPIN(xb_ld(&bar[XB_TOPGEN]) == tg, bar);
            __builtin_amdgcn_fence(__ATOMIC_ACQUIRE, "agent");
            xb_add(&bar[XB_XGEN(b.x)], 1u);
            asm volatile("s_waitcnt vmcnt(0)" ::: "memory");
        } else {
            XB_SPIN(xb_ld(&bar[XB_XGEN(b.x)]) == gen, bar);
            __builtin_amdgcn_fence(__ATOMIC_ACQUIRE, "agent");
            asm volatile("s_waitcnt vmcnt(0)" ::: "memory");
        }
    }
    __syncthreads();
}

__global__ void __launch_bounds__(512, 2) fwd_megakernel(Params P) {
    extern __shared__ __attribute__((aligned(16))) unsigned char lds[];
    cg::grid_group grid = cg::this_grid();
    const int tid = threadIdx.x, lane = tid & 63, wave = __builtin_amdgcn_readfirstlane(tid >> 6);
    unsigned char* ws = P.ws;
    const int lo = P.ph_lo, hi = P.ph_hi;
#ifndef PHMASK
#define PHMASK 255
#endif
#define IN(k) (((PHMASK >> (k)) & 1) && lo <= (k) && (k) < hi)
#define SEAM(k) do { if (IN(k) && IN((k) + 1)) xcd_barrier(bar); } while (0)
    volatile LAS unsigned* MISC = (volatile LAS unsigned*)((LAS unsigned char*)lds + LDS_MISC_OFF);
    if (tid < 2) MISC[tid] = 0u;
    __syncthreads();
    const XcdBarrier bar = xcd_barrier_post((unsigned*)(ws + OFF_BAR), MISC);
    if (hi < 0) grid.sync();
    PG8_LAS unsigned char* ring = (PG8_LAS unsigned char*)lds;
    bf16* XB = (bf16*)(ws + OFF_XB); bf16* QKVU = (bf16*)(ws + OFF_QKVU); bf16* Y = (bf16*)(ws + OFF_Y); bf16* UPB = (bf16*)(ws + OFF_UP);
    bf16* GATES = (bf16*)P.out; float* ss2 = (float*)(ws + OFF_SS2);
    if (IN(0)) { for (int rep = 0; rep < REPS(0); ++rep) { p0_prologue(P, lds, tid, wave, lane); __syncthreads(); } }
    SEAM(0);
#ifdef EXTRA_SYNCS
    for (int i_ = 0; i_ < EXTRA_SYNCS; ++i_) xcd_barrier(bar);
#endif
    if (IN(1)) {
        pg8::Gemm gm{XB, (const bf16*)(ws + OFF_WIN), M, NIN, D}; pg8::StaticOrder S; S.init(M, NIN, gridDim.x, (int)blockIdx.x);
        EpiProj E{QKVU, (bf16*)(ws + OFF_UG), GATES};
        for (int rep = 0; rep < REPS(1); ++rep)
        pg8::gemm_phase<EpiProj, pg8::StaticOrder, true, true>(ring, gm, S, E);
    }
    SEAM(1);
    if (IN(2)) {
        attn_phase(P, lds, tid, wave, lane); __syncthreads();
        for (int rep = 0; rep < REPS(2); ++rep) ssm_phase(P, lds, tid, wave, lane);
    }
    SEAM(2);
    if (IN(4)) {
        pg8::Gemm gm{Y, (const bf16*)(ws + OFF_WGLU), M, D, D}; pg8::StaticOrder S; S.init(M, D, gridDim.x, (int)blockIdx.x);
        EpiGlu E{Y, QKVU, (const bf16*)((const unsigned char*)P.out + 1024), P.b_glu, XB};
        for (int rep = 0; rep < REPS(4); ++rep)
        pg8::gemm_phase<EpiGlu, pg8::StaticOrder, true, true>(ring, gm, S, E);
    }
    SEAM(4);
    if (IN(5)) {
        pg8::Gemm gm{XB, (const bf16*)(ws + OFF_WOUT), M, D, D}; pg8::StaticOrder S; S.init(M, D, gridDim.x, (int)blockIdx.x);
        EpiOut E{P.xp, P.xs, P.out, Y, ss2};
        pg8::gemm_phase<EpiOut, pg8::StaticOrder, true, true>(ring, gm, S, E);
    }
    SEAM(5);
    if (IN(6)) {
        pg8::Gemm gm{Y, (const bf16*)(ws + OFF_WUP), M, FF, D}; pg8::StaticOrder S; S.init(M, FF, gridDim.x, (int)blockIdx.x);
        EpiUp E{ss2, UPB};
        for (int rep = 0; rep < REPS(6); ++rep)
        pg8::gemm_phase<EpiUp, pg8::StaticOrder, true, true>(ring, gm, S, E);
    }
    SEAM(6);
    if (IN(7)) {
        pg8::Gemm gm{UPB, (const bf16*)(ws + OFF_WDN), M, D, FF}; pg8::StaticOrder S; S.init(M, D, gridDim.x, (int)blockIdx.x);
        EpiDown E{P.out, Y};
        pg8::gemm_phase<EpiDown, pg8::StaticOrder, true, true>(ring, gm, S, E);
    }
#undef IN
#undef SEAM
}

#ifndef MK_N_LAUNCHES
#define MK_N_LAUNCHES 1
#endif
extern "C" void kernel_launch(void* const* d_in, const int* in_sizes, int n_in, void* d_out, int out_size, void* d_ws, size_t ws_size, hipStream_t stream) {
    static int grid = 0;
    if (grid == 0) {
        if (n_in != 22 || out_size != M * D || ws_size < WS_NEED) { fprintf(stderr, "kernel_launch: unexpected shapes (n_in %d out %d ws %zu)\n", n_in, out_size, ws_size); grid = -1; return; }
        int dev = 0, cus = 0, per_cu = 0;
        hipGetDevice(&dev); hipDeviceGetAttribute(&cus, hipDeviceAttributeMultiprocessorCount, dev);
        if (hipFuncSetAttribute((const void*)fwd_megakernel, hipFuncAttributeMaxDynamicSharedMemorySize, LDS_BYTES) != hipSuccess) { fprintf(stderr, "kernel_launch: hipFuncSetAttribute failed\n"); grid = -1; return; }
        if (hipOccupancyMaxActiveBlocksPerMultiprocessor(&per_cu, (const void*)fwd_megakernel, 512, LDS_BYTES) != hipSuccess || per_cu < 1) { fprintf(stderr, "kernel_launch: occupancy query says %d\n", per_cu); per_cu = 1; }
        (void)hipGetLastError();
        grid = cus;
    }
    if (grid < 0) return;
    Params p{};
    const float** f = &p.xp;
    for (int i = 0; i < 22; ++i) f[i] = (const float*)d_in[i];
    p.out = (float*)d_out; p.ws = (unsigned char*)d_ws;
    if (hipMemsetAsync((char*)d_ws + OFF_BAR, 0, 16384, stream) != hipSuccess) { fprintf(stderr, "kernel_launch: hipMemsetAsync failed\n"); return; }
    if (MK_N_LAUNCHES == 1) {
        p.ph_lo = 0; p.ph_hi = 8;
        void* args[] = {&p};
        hipError_t e = hipLaunchCooperativeKernel((const void*)fwd_megakernel, dim3(grid), dim3(512), args, LDS_BYTES, stream);
        if (e != hipSuccess) fprintf(stderr, "cooperative launch failed: %s (grid %d)\n", hipGetErrorString(e), grid);
    } else {
        for (int ph = 0; ph < 8; ++ph) { p.ph_lo = ph; p.ph_hi = ph + 1;
            void* args[] = {&p};
            hipError_t e = hipLaunchCooperativeKernel((const void*)fwd_megakernel, dim3(grid), dim3(512), args, LDS_BYTES, stream);
            if (e != hipSuccess) { fprintf(stderr, "launch %d failed: %s\n", ph, hipGetErrorString(e)); break; } }
    }
}
```
